# Optimizing an MI355X kernel written in HIP

```python
import jax, jax.numpy as jnp
from jax import lax
import numpy as np

D_MODEL = 1024
BATCH = 16
SEQ = 2048
DEPTH = 2

MIX_WIDTH = D_MODEL
SSD_WIDTH = MIX_WIDTH // 2
SSD_HEADDIM = 64
SSD_HEADS = SSD_WIDTH // SSD_HEADDIM
SSD_GROUPS = 2
SSD_STATE = 128
SSD_CONV = 5
SSD_CHUNK = 128
RWKV_WIDTH = MIX_WIDTH - SSD_WIDTH
RWKV_HEADSIZE = 64
RWKV_HEADS = RWKV_WIDTH // RWKV_HEADSIZE
DECAY_LORA = 64
ICLR_LORA = 64
GATE_LORA = 128
D_FF = 4 * D_MODEL

ALPHA = float((2 * DEPTH) ** 0.25)
BETA = float((8 * DEPTH) ** -0.25)
LN_EPS = 1e-5
RMS_EPS = 1e-5
GN_EPS = 64e-5

SSD_XBC = SSD_WIDTH + 2 * SSD_GROUPS * SSD_STATE
SSD_COLS = SSD_WIDTH + SSD_XBC + 2 * SSD_HEADS
RWKV_COLS = 3 * RWKV_WIDTH + DECAY_LORA + ICLR_LORA + GATE_LORA
IN_COLS = SSD_COLS + RWKV_COLS

kernel_name = "hymba_ssd_rwkv7_deepnorm_encoder"


def layer_norm(x, g, b):
    xf = x.astype(jnp.float32)
    mu = jnp.mean(xf, -1, keepdims=True)
    var = jnp.mean(jnp.square(xf - mu), -1, keepdims=True)
    return ((xf - mu) * lax.rsqrt(var + LN_EPS) * g + b).astype(x.dtype)


def centred_depthwise_conv(u, w, b):
    pad = (w.shape[0] - 1) // 2
    y = lax.conv_general_dilated(u, w[:, None, :].astype(u.dtype), window_strides=(1,),
                                 padding=[(pad, pad)], dimension_numbers=('NWC', 'WIO', 'NWC'),
                                 feature_group_count=u.shape[-1])
    return y + b


def segsum_exp(a):
    n = a.shape[-1]
    cs = jnp.cumsum(a, -1)
    diff = cs[..., :, None] - cs[..., None, :]
    mask = jnp.tril(jnp.ones((n, n), dtype=bool))
    return jnp.exp(jnp.where(mask, diff, -jnp.inf))


def ssd_chunked(xs, a, Bm, Cm):
    b, T, H, P = xs.shape
    G, N = Bm.shape[2], Bm.shape[3]
    E = H // G
    c = T // SSD_CHUNK
    L = SSD_CHUNK
    f32 = jnp.float32
    x = xs.astype(f32).reshape(b, c, L, G, E, P)
    a = a.astype(f32).reshape(b, c, L, G, E).transpose(0, 3, 4, 1, 2)
    Bc = Bm.astype(f32).reshape(b, c, L, G, N)
    Cc = Cm.astype(f32).reshape(b, c, L, G, N)
    a_cs = jnp.cumsum(a, -1)
    lmat = segsum_exp(a)
    scores = jnp.einsum('bclgn,bcsgn->bgcls', Cc, Bc)
    y_diag = jnp.einsum('bgecls,bcsgep->bclgep', scores[:, :, None] * lmat, x)
    decay_states = jnp.exp(a_cs[..., -1:] - a_cs)
    states = jnp.einsum('bclgn,bgecl,bclgep->bcgepn', Bc, decay_states, x)
    a_last = jnp.pad(a_cs[..., -1], ((0, 0), (0, 0), (0, 0), (1, 0)))
    chunk_decay = segsum_exp(a_last)
    states = jnp.concatenate([jnp.zeros_like(states[:, :1]), states], 1)
    states_in = jnp.einsum('bgezc,bcgepn->bzgepn', chunk_decay, states)[:, :-1]
    y_off = jnp.einsum('bclgn,bcgepn,bgecl->bclgep', Cc, states_in, jnp.exp(a_cs))
    return (y_diag + y_off).reshape(b, T, H, P)


def ssd_bidir(z, xbc, dt_raw, conv_w, conv_b, dt_bias, a_log, d_skip, norm_g):
    b, T, _ = z.shape
    H, P, G, N = SSD_HEADS, SSD_HEADDIM, SSD_GROUPS, SSD_STATE
    xbc = jax.nn.silu(centred_depthwise_conv(xbc, conv_w, conv_b))
    xs = xbc[..., :SSD_WIDTH].reshape(b, T, H, P).astype(jnp.float32)
    Bm = xbc[..., SSD_WIDTH:SSD_WIDTH + G * N].reshape(b, T, G, N)
    Cm = xbc[..., SSD_WIDTH + G * N:].reshape(b, T, G, N)
    dt = jax.nn.softplus(dt_raw.reshape(b, T, 2, H).astype(jnp.float32) + dt_bias)
    da = dt * (-jnp.exp(a_log.astype(jnp.float32)))
    flip = lambda t: jnp.flip(t, 1)
    y_f = ssd_chunked(xs * dt[:, :, 0, :, None], da[:, :, 0], Bm, Cm)
    y_b = flip(ssd_chunked(flip(xs * dt[:, :, 1, :, None]), flip(da[:, :, 1]), flip(Bm), flip(Cm)))
    y = (y_f + y_b + d_skip[:, None] * xs).reshape(b, T, SSD_WIDTH)
    y = (y * jax.nn.silu(z.astype(jnp.float32))).reshape(b, T, G, SSD_WIDTH // G)
    y = y * lax.rsqrt(jnp.mean(y * y, -1, keepdims=True) + RMS_EPS)
    return y.reshape(b, T, SSD_WIDTH) * norm_g


def centred_token_shift(u, mu):
    p = jnp.pad(u, ((0, 0), (1, 1), (0, 0)))
    neighbours = 0.5 * (p[:, :-2] + p[:, 2:])
    return u + (neighbours - u) * mu


def rwkv7_step(S, inp):
    r, w, k, v, kk, a = inp
    s_kk = jnp.einsum('dbhvk,dbhk->dbhv', S, kk)
    S = S * w[..., None, :] - s_kk[..., None] * (kk * a)[..., None, :] + v[..., :, None] * k[..., None, :]
    y = jnp.einsum('dbhvk,dbhk->dbhv', S, r)
    return S, y


def _directional(t_f, t_b):
    t = jnp.stack([t_f, jnp.flip(t_b, 1)], 0)
    return jnp.moveaxis(t, 2, 0)


def rwkv7_bidir(u, mu, w0, w_up, a0, a_up, g_up, k_k, k_a, r_k, lnx_g, lnx_b):
    b, T, _ = u.shape
    H, N, W = RWKV_HEADS, RWKV_HEADSIZE, RWKV_WIDTH
    f32 = jnp.float32
    heads = lambda t: t.reshape(t.shape[:-1] + (H, N)).astype(f32)
    u = centred_token_shift(u, mu)
    o1, o2, o3 = W, 2 * W, 3 * W
    o4, o5 = o3 + DECAY_LORA, o3 + DECAY_LORA + ICLR_LORA
    r, k, v = u[..., :o1], u[..., o1:o2], u[..., o2:o3]
    xw, xa, xg = u[..., o3:o4], u[..., o4:o5], u[..., o5:]
    w_log = -jax.nn.softplus(-(w0 + jnp.einsum('btr,drc->btdc', jnp.tanh(xw), w_up))) - 0.5
    decay = jnp.exp(-jnp.exp(w_log.astype(f32)))
    a = jax.nn.sigmoid(a0 + jnp.einsum('btr,drc->btdc', xa, a_up))
    g = jax.nn.sigmoid(xg) @ g_up
    kk = heads(k * k_k)
    kk = kk / jnp.maximum(jnp.sqrt(jnp.sum(kk * kk, -1, keepdims=True)), 1e-12)
    k_dir = k[:, :, None] * (1.0 + (a - 1.0) * k_a)
    rh, vh = heads(r), heads(v)
    kd, ad, wd = heads(k_dir), heads(a), heads(decay)
    inputs = (_directional(rh, rh), _directional(wd[:, :, 0], wd[:, :, 1]),
              _directional(kd[:, :, 0], kd[:, :, 1]), _directional(vh, vh),
              _directional(kk, kk), _directional(ad[:, :, 0], ad[:, :, 1]))
    S0 = jnp.zeros((2, b, H, N, N), f32)
    _, ys = lax.scan(rwkv7_step, S0, inputs)
    y = jnp.moveaxis(ys[:, 0], 0, 1) + jnp.flip(jnp.moveaxis(ys[:, 1], 0, 1), 1)
    mu_y = jnp.mean(y, -1, keepdims=True)
    var_y = jnp.mean(jnp.square(y - mu_y), -1, keepdims=True)
    y = ((y - mu_y) * lax.rsqrt(var_y + GN_EPS)).reshape(b, T, W) * lnx_g + lnx_b
    bonus = jnp.sum(jnp.sum(rh[:, :, None] * kd * r_k, -1, keepdims=True), 2) * vh
    return (y + bonus.reshape(b, T, W)) * g


def hybrid_mixer(h, w_in, conv_w, conv_b, dt_bias, a_log, d_skip, ssd_norm_g,
                 mu_rwkv, w0, w_up, a0, a_up, g_up, k_k, k_a, r_k, lnx_g, lnx_b, w_out):
    proj = h @ w_in
    z = proj[..., :SSD_WIDTH]
    xbc = proj[..., SSD_WIDTH:SSD_WIDTH + SSD_XBC]
    dt_raw = proj[..., SSD_WIDTH + SSD_XBC:SSD_COLS]
    rw = proj[..., SSD_COLS:]
    y_ssd = ssd_bidir(z, xbc, dt_raw, conv_w, conv_b, dt_bias, a_log, d_skip, ssd_norm_g)
    y_rwkv = rwkv7_bidir(rw, mu_rwkv, w0, w_up, a0, a_up, g_up, k_k, k_a, r_k, lnx_g, lnx_b)
    y = jnp.concatenate([y_ssd, y_rwkv], -1).astype(h.dtype)
    return y @ w_out


def sq_relu_mlp(h, w_fc, w_proj):
    return jnp.square(jax.nn.relu(h @ w_fc)) @ w_proj


def setup_inputs(seed: int = 0) -> dict:
    key = jax.random.key(seed)
    ks = jax.random.split(key, 32)
    f32 = jnp.float32
    nrm = lambda k, s: jax.random.normal(k, s, f32)
    uni = lambda k, s, lo, hi: jax.random.uniform(k, s, f32, lo, hi)
    col_scale = np.ones((IN_COLS,), np.float32)
    col_scale[SSD_WIDTH:2 * SSD_WIDTH] = BETA
    col_scale[SSD_COLS + 2 * RWKV_WIDTH:SSD_COLS + 3 * RWKV_WIDTH] = BETA
    dt0 = jnp.exp(uni(ks[5], (DEPTH, 2, SSD_HEADS), float(np.log(1e-3)), float(np.log(1e-1))))
    return {
        "x": nrm(ks[0], (BATCH, SEQ, D_MODEL)),
        "ln0_g": 1.0 + 0.02 * nrm(ks[1], (D_MODEL,)),
        "ln0_b": 0.02 * nrm(ks[2], (D_MODEL,)),
        "w_in": nrm(ks[3], (DEPTH, D_MODEL, IN_COLS)) * (D_MODEL ** -0.5) * jnp.asarray(col_scale),
        "conv_w": nrm(ks[4], (DEPTH, SSD_CONV, SSD_XBC)) * (SSD_CONV ** -0.5),
        "conv_b": 0.02 * nrm(ks[6], (DEPTH, SSD_XBC)),
        "dt_bias": dt0 + jnp.log(-jnp.expm1(-dt0)),
        "a_log": jnp.log(uni(ks[7], (DEPTH, 2, SSD_HEADS), 1.0, 16.0)),
        "d_skip": 1.0 + 0.02 * nrm(ks[8], (DEPTH, SSD_HEADS)),
        "ssd_norm_g": 1.0 + 0.02 * nrm(ks[9], (DEPTH, SSD_WIDTH)),
        "mu_rwkv": uni(ks[10], (DEPTH, RWKV_COLS), 0.0, 1.0),
        "w0": uni(ks[11], (DEPTH, 2, RWKV_WIDTH), -6.5, -1.5),
        "w_up": 0.1 * nrm(ks[12], (DEPTH, 2, DECAY_LORA, RWKV_WIDTH)) * (DECAY_LORA ** -0.5),
        "a0": 0.1 * nrm(ks[13], (DEPTH, 2, RWKV_WIDTH)),
        "a_up": 0.5 * nrm(ks[14], (DEPTH, 2, ICLR_LORA, RWKV_WIDTH)) * (ICLR_LORA ** -0.5),
        "g_up": nrm(ks[15], (DEPTH, GATE_LORA, RWKV_WIDTH)) * (GATE_LORA ** -0.5),
        "k_k": 0.85 + 0.02 * nrm(ks[16], (DEPTH, RWKV_WIDTH)),
        "k_a": 1.0 + 0.02 * nrm(ks[17], (DEPTH, RWKV_WIDTH)),
        "r_k": -0.04 + 0.02 * nrm(ks[18], (DEPTH, RWKV_HEADS, RWKV_HEADSIZE)),
        "lnx_g": 1.0 + 0.02 * nrm(ks[19], (DEPTH, RWKV_WIDTH)),
        "lnx_b": 0.02 * nrm(ks[20], (DEPTH, RWKV_WIDTH)),
        "w_out": nrm(ks[21], (DEPTH, MIX_WIDTH, D_MODEL)) * (MIX_WIDTH ** -0.5) * BETA,
        "ln1_g": 1.0 + 0.02 * nrm(ks[22], (DEPTH, D_MODEL)),
        "ln1_b": 0.02 * nrm(ks[23], (DEPTH, D_MODEL)),
        "w_fc": nrm(ks[24], (DEPTH, D_MODEL, D_FF)) * (D_MODEL ** -0.5),
        "w_proj": nrm(ks[25], (DEPTH, D_FF, D_MODEL)) * (D_FF ** -0.5) * BETA,
        "ln2_g": 1.0 + 0.02 * nrm(ks[26], (DEPTH, D_MODEL)),
        "ln2_b": 0.02 * nrm(ks[27], (DEPTH, D_MODEL)),
    }


def reference(x, ln0_g, ln0_b, w_in, conv_w, conv_b, dt_bias, a_log, d_skip, ssd_norm_g,
              mu_rwkv, w0, w_up, a0, a_up, g_up, k_k, k_a, r_k, lnx_g, lnx_b, w_out,
              ln1_g, ln1_b, w_fc, w_proj, ln2_g, ln2_b):
    h = layer_norm(x, ln0_g, ln0_b)
    for l in range(DEPTH):
        mix = hybrid_mixer(h, w_in[l], conv_w[l], conv_b[l], dt_bias[l], a_log[l], d_skip[l],
                           ssd_norm_g[l], mu_rwkv[l], w0[l], w_up[l], a0[l], a_up[l], g_up[l],
                           k_k[l], k_a[l], r_k[l], lnx_g[l], lnx_b[l], w_out[l])
        h = layer_norm(ALPHA * h + mix, ln1_g[l], ln1_b[l])
        h = layer_norm(ALPHA * h + sq_relu_mlp(h, w_fc[l], w_proj[l]), ln2_g[l], ln2_b[l])
    return h
```

```cpp
#include <hip/hip_runtime.h>
#include <hip/hip_bf16.h>
#include <hip/hip_cooperative_groups.h>
#include <cstdio>
namespace cg = cooperative_groups;

#ifndef COOP
#define COOP 0
#endif

typedef unsigned short u16;
typedef unsigned int u32;
using bf16x8 = __attribute__((ext_vector_type(8))) short;
using f32x4 = __attribute__((ext_vector_type(4))) float;
using f32x16 = __attribute__((ext_vector_type(16))) float;

constexpr int MTOK = 32768, SEQ = 2048, DM = 1024, DFF = 4096;
constexpr int NPROJ = 3456;
constexpr int SSD_COLS = 1552;
constexpr float ALPHA = 1.4142135623730951f;
constexpr float LN_EPS = 1e-5f, RMS_EPS = 1e-5f, GN_EPS = 64e-5f;

enum { IX=0, ILN0G, ILN0B, IWIN, ICONVW, ICONVB, IDTB, IALOG, IDSKIP, ISSDG, IMU, IW0, IWUP, IA0, IAUP, IGUP,
       IKK, IKA, IRK, ILNXG, ILNXB, IWOUT, ILN1G, ILN1B, IWFC, IWPROJ, ILN2G, ILN2B, NIN };

constexpr size_t OFF_WIN = 0;
constexpr size_t OFF_WOUT = 7340032;
constexpr size_t OFF_WFC = 9437184;
constexpr size_t OFF_WPROJ = 17825792;
constexpr size_t OFF_WLORA = 26214400;
constexpr size_t OFF_H = 27525120;
constexpr size_t OFF_XS = OFF_H;
constexpr size_t OFF_BM = OFF_H + 33554432;
constexpr size_t OFF_CM = OFF_H + 50331648;
constexpr size_t OFF_P = OFF_H + 67108864;
constexpr size_t OFF_E = OFF_P;
constexpr size_t OFF_A = OFF_P + 67108864;
constexpr size_t OFF_G = OFF_P + 134217728;
constexpr size_t OFF_YR = OFF_P + 167772160;
constexpr size_t OFF_YMIX = OFF_P;
constexpr size_t OFF_ACT = OFF_P;
constexpr size_t OFF_S = OFF_P + 234881024;
constexpr size_t OFF_Q = OFF_S + 67108864;
constexpr size_t OFF_R = OFF_Q;
constexpr size_t OFF_K = OFF_Q + 33554432;
constexpr size_t OFF_V = OFF_Q + 67108864;
constexpr size_t OFF_SZ = OFF_Q + 100663296;
constexpr size_t OFF_PRE = OFF_Q;
constexpr size_t OFF_SM = OFF_Q + 134217728;
constexpr size_t OFF_DT = OFF_SM;
constexpr size_t OFF_INVN = OFF_SM + 2097152;
constexpr size_t WS_NEED = OFF_SM + 4194304;

struct Params {
  const float* in[NIN];
  float* out;
  char* ws;
};
struct Ctx { int tid, bid, nb; };

__device__ __forceinline__ u16 f2bf(float f) {
  u32 u = __float_as_uint(f);
  u += 0x7fffu + ((u >> 16) & 1u);
  return (u16)(u >> 16);
}
__device__ __forceinline__ float bf2f(u16 h) { return __uint_as_float(((u32)h) << 16); }
__device__ __forceinline__ float bflo(u32 w) { return __uint_as_float(w << 16); }
__device__ __forceinline__ float bfhi(u32 w) { return __uint_as_float(w & 0xffff0000u); }
__device__ __forceinline__ u32 pack2(float a, float b) { return (u32)f2bf(a) | ((u32)f2bf(b) << 16); }
__device__ __forceinline__ float sigmoidf_(float x) { return 1.f / (1.f + __expf(-x)); }
__device__ __forceinline__ float siluf_(float x) { return x / (1.f + __expf(-x)); }
__device__ __forceinline__ float softplusf_(float x) { return fmaxf(x, 0.f) + log1pf(__expf(-fabsf(x))); }
__device__ __forceinline__ float wave_sum(float v) {
#pragma unroll
  for (int o = 32; o >= 1; o >>= 1) v += __shfl_xor(v, o);
  return v;
}

struct EpiProj {
  u16* proj; float* dt;
  __device__ __forceinline__ void operator()(int row, int col, float v) const {
    proj[(size_t)row * NPROJ + col] = f2bf(v);
    if (col >= 1536 && col < 1552) dt[(size_t)row * 16 + (col - 1536)] = v;
  }
};
struct EpiLora {
  u16* e; u16* a; u16* g; const float* w0; const float* a0;
  __device__ __forceinline__ void operator()(int row, int col, float v) const {
    if (col < 1024) {
      int d = col >> 9, c = col & 511;
      float x = w0[col] + v;
      e[((size_t)d * MTOK + row) * 512 + c] = f2bf(0.6065306597126334f * sigmoidf_(x));
    } else if (col < 2048) {
      int cc = col - 1024, d = cc >> 9, c = cc & 511;
      a[((size_t)d * MTOK + row) * 512 + c] = f2bf(sigmoidf_(a0[cc] + v));
    } else {
      g[(size_t)row * 512 + (col - 2048)] = f2bf(v);
    }
  }
};
struct EpiResid {
  float* pre; const float* h;
  __device__ __forceinline__ void operator()(int row, int col, float v) const {
    size_t o = (size_t)row * DM + col;
    pre[o] = ALPHA * h[o] + v;
  }
};
struct EpiRelu2 {
  u16* act;
  __device__ __forceinline__ void operator()(int row, int col, float v) const {
    float r = fmaxf(v, 0.f);
    act[(size_t)row * DFF + col] = f2bf(r * r);
  }
};

constexpr int BM = 256, BN = 128, BK = 64, NXCD = 8, WGM = 8;
constexpr int SHM_BYTES = 98304;

__device__ __forceinline__ int lds_byte(int r, int c) {
  int st = (r >> 4) * 2 + (c >> 5), rr = r & 15, cc = c & 31, ob = rr * 64 + cc * 2;
  return st * 1024 + (ob ^ (((ob >> 9) & 1) << 5));
}
__device__ __forceinline__ void stage_rc(int b, int& R, int& C) {
  int st = b / 1024, sb = b % 1024, swz = sb ^ (((sb >> 9) & 1) << 5);
  R = (st >> 1) * 16 + swz / 64; C = (st & 1) * 32 + (swz % 64) / 2;
}

struct GemmDesc {
  const u16* A; const u16* Bt; int N, K, kind;
  EpiProj eproj; EpiLora elora; EpiResid eres; EpiRelu2 erelu;
};

__device__ __forceinline__ void gemm_phase(const Ctx c, const GemmDesc& gd, char* shm) {
  const u16* __restrict__ A = gd.A; const u16* __restrict__ Bt = gd.Bt;
  const int M = MTOK, N = gd.N, K = gd.K;
  constexpr int TILE_A = BM * BK * 2, TILE_B = BN * BK * 2, GLA = TILE_A / 8192, GLB = TILE_B / 8192, STAGE_B = TILE_A + TILE_B;
#define SA(b) (shm + (b) * STAGE_B)
#define SB(b) (shm + (b) * STAGE_B + TILE_A)
#define WAIT_V(n) asm volatile("s_waitcnt vmcnt(%0)" ::"n"(n) : "memory")
#define SCHED() __builtin_amdgcn_sched_barrier(0)
  const int nM = M / BM, nN = N / BN, nwg = nM * nN;
  const int tid = c.tid, wid = tid >> 6, lane = tid & 63, wr = wid >> 1, wc = wid & 1, fr = lane & 15, fq = lane >> 4;
  const int nt = K / BK;
  int sR[GLA], sC[GLA];
#pragma unroll
  for (int i = 0; i < GLA; ++i) stage_rc(wid * 1024 + i * 8192 + lane * 16, sR[i], sC[i]);
#define GSRC(base, i, kt) ((base) + (long)sR[i] * K + (kt) * BK + sC[i])
#define GLDS_STAGE(buf, kt) do { \
    _Pragma("unroll") for (int i = 0; i < GLA; ++i) \
      __builtin_amdgcn_global_load_lds((const u32*)GSRC(Ab, i, kt), (u32*)(SA(buf) + wid * 1024 + i * 8192), 16, 0, 0); \
    _Pragma("unroll") for (int i = 0; i < GLB; ++i) \
      __builtin_amdgcn_global_load_lds((const u32*)GSRC(Bb, i, kt), (u32*)(SB(buf) + wid * 1024 + i * 8192), 16, 0, 0); } while (0)
#define KREAD(buf, ks) \
    _Pragma("unroll") for (int m = 0; m < 4; ++m) At[m] = *(const bf16x8*)(SA(buf) + lds_byte(wr * 64 + m * 16 + fr, (ks) * 32 + fq * 8)); \
    _Pragma("unroll") for (int n = 0; n < 4; ++n) Bf[n] = *(const bf16x8*)(SB(buf) + lds_byte(wc * 64 + n * 16 + fr, (ks) * 32 + fq * 8))
#define KMMA() _Pragma("unroll") for (int m = 0; m < 4; ++m) _Pragma("unroll") for (int n = 0; n < 4; ++n) \
    acc[m][n] = __builtin_amdgcn_mfma_f32_16x16x32_bf16(At[m], Bf[n], acc[m][n], 0, 0, 0)
#define KSTEP(buf, ks) do { bf16x8 At[4], Bf[4]; KREAD(buf, ks); KMMA(); SCHED(); } while (0)
#define COMPUTE(buf) do { KSTEP(buf, 0); KSTEP(buf, 1); } while (0)

  for (int wg0 = c.bid; wg0 < nwg; wg0 += c.nb) {
    int wgid = wg0;
    { int q = nwg / NXCD, r = nwg % NXCD, xcd = wgid % NXCD, off = wgid / NXCD;
      wgid = (xcd < r ? xcd * (q + 1) : r * (q + 1) + (xcd - r) * q) + off; }
    int nig = WGM * nN, gid = wgid / nig, fm = gid * WGM, gsz = min(nM - fm, WGM);
    int pm = fm + ((wgid % nig) % gsz), pn = (wgid % nig) / gsz, brow = pm * BM, bcol = pn * BN;
    const u16* Ab = A + (long)brow * K;
    const u16* Bb = Bt + (long)bcol * K;
    f32x4 acc[4][4];
#pragma unroll
    for (int m = 0; m < 4; ++m)
#pragma unroll
      for (int n = 0; n < 4; ++n) acc[m][n] = f32x4{0.f, 0.f, 0.f, 0.f};
    GLDS_STAGE(0, 0); WAIT_V(0); __syncthreads();
    for (int t = 0; t < nt; ++t) {
      int cur = t & 1;
      if (t + 1 < nt) GLDS_STAGE(cur ^ 1, t + 1);
      COMPUTE(cur);
      WAIT_V(0); __syncthreads();
    }
#define EPILOOP(EPI) \
    _Pragma("unroll") for (int m = 0; m < 4; ++m) \
    _Pragma("unroll") for (int n = 0; n < 4; ++n) \
    _Pragma("unroll") for (int j = 0; j < 4; ++j) \
      EPI(brow + wr * 64 + m * 16 + fq * 4 + j, bcol + wc * 64 + n * 16 + fr, acc[m][n][j]);
    if (gd.kind == 0) { EPILOOP(gd.eproj) }
    else if (gd.kind == 1) { EPILOOP(gd.elora) }
    else if (gd.kind == 2) { EPILOOP(gd.eres) }
    else { EPILOOP(gd.erelu) }
#undef EPILOOP
  }
#undef SA
#undef SB
#undef GSRC
#undef GLDS_STAGE
#undef KREAD
#undef KMMA
#undef KSTEP
#undef COMPUTE
}

__device__ void transpose_convert(const Ctx c, const float* __restrict__ src, u16* __restrict__ dst, int K, int N, int Npad, float* lds) {
  const int tid = c.tid;
  const int tk = K / 64, tn = Npad / 64, ntile = tk * tn;
  for (int t = c.bid; t < ntile; t += c.nb) {
    int k0 = (t % tk) * 64, n0 = (t / tk) * 64;
    __syncthreads();
#pragma unroll
    for (int i = 0; i < 8; ++i) {
      int kk = i * 8 + (tid >> 6), nn = tid & 63;
      float v = (n0 + nn < N) ? src[(size_t)(k0 + kk) * N + n0 + nn] : 0.f;
      lds[kk * 65 + nn] = v;
    }
    __syncthreads();
#pragma unroll
    for (int i = 0; i < 8; ++i) {
      int nn = i * 8 + (tid >> 6), kk = tid & 63;
      dst[(size_t)(n0 + nn) * K + k0 + kk] = f2bf(lds[kk * 65 + nn]);
    }
  }
}

__device__ void convert_weights(const Ctx c, const Params& p, int l, char* shm) {
  float* lds = (float*)shm;
  transpose_convert(c, p.in[IWIN] + (size_t)l * 1024 * 3344, (u16*)(p.ws + OFF_WIN), 1024, 3344, NPROJ, lds);
  transpose_convert(c, p.in[IWOUT] + (size_t)l * 1024 * 1024, (u16*)(p.ws + OFF_WOUT), 1024, 1024, 1024, lds);
  transpose_convert(c, p.in[IWFC] + (size_t)l * 1024 * 4096, (u16*)(p.ws + OFF_WFC), 1024, 4096, 4096, lds);
  transpose_convert(c, p.in[IWPROJ] + (size_t)l * 4096 * 1024, (u16*)(p.ws + OFF_WPROJ), 4096, 1024, 1024, lds);
  u16* wl = (u16*)(p.ws + OFF_WLORA);
  const float* wup = p.in[IWUP] + (size_t)l * 2 * 64 * 512;
  const float* aup = p.in[IAUP] + (size_t)l * 2 * 64 * 512;
  const float* gup = p.in[IGUP] + (size_t)l * 128 * 512;
  for (int idx = c.bid * 512 + c.tid; idx < 2560 * 256; idx += c.nb * 512) {
    int n = idx >> 8, k = idx & 255;
    float v = 0.f;
    if (n < 1024) { if (k < 64) { int d = n >> 9, c = n & 511; v = wup[((size_t)d * 64 + k) * 512 + c]; } }
    else if (n < 2048) { if (k >= 64 && k < 128) { int d = (n - 1024) >> 9, c = n & 511; v = aup[((size_t)d * 64 + (k - 64)) * 512 + c]; } }
    else { if (k >= 128) { int c = n - 2048; v = gup[(size_t)(k - 128) * 512 + c]; } }
    wl[idx] = f2bf(v);
  }
}

__device__ void ln_phase(const Ctx c, const float* __restrict__ src, const float* __restrict__ g, const float* __restrict__ b,
                         float* __restrict__ dstf, u16* __restrict__ dstb) {
  const int wave = c.tid >> 6, lane = c.tid & 63;
  for (int row = c.bid * 8 + wave; row < MTOK; row += c.nb * 8) {
    const float4* s = (const float4*)(src + (size_t)row * DM);
    float4 v[4];
    float sum = 0.f;
#pragma unroll
    for (int i = 0; i < 4; ++i) { v[i] = s[lane + 64 * i]; sum += v[i].x + v[i].y + v[i].z + v[i].w; }
    float mean = wave_sum(sum) * (1.f / DM);
    float sq = 0.f;
#pragma unroll
    for (int i = 0; i < 4; ++i) {
      float a = v[i].x - mean, bb = v[i].y - mean, c = v[i].z - mean, d = v[i].w - mean;
      sq += a * a + bb * bb + c * c + d * d;
    }
    float rstd = rsqrtf(wave_sum(sq) * (1.f / DM) + LN_EPS);
#pragma unroll
    for (int i = 0; i < 4; ++i) {
      float4 gg = ((const float4*)g)[lane + 64 * i], bb = ((const float4*)b)[lane + 64 * i];
      float4 o;
      o.x = (v[i].x - mean) * rstd * gg.x + bb.x; o.y = (v[i].y - mean) * rstd * gg.y + bb.y;
      o.z = (v[i].z - mean) * rstd * gg.z + bb.z; o.w = (v[i].w - mean) * rstd * gg.w + bb.w;
      ((float4*)(dstf + (size_t)row * DM))[lane + 64 * i] = o;
      uint2 pk; pk.x = pack2(o.x, o.y); pk.y = pack2(o.z, o.w);
      ((uint2*)(dstb + (size_t)row * DM))[lane + 64 * i] = pk;
    }
  }
}

__device__ void prep_phase(const Ctx c, const Params& p, int l) {
  const int wave = c.tid >> 6, lane = c.tid & 63;
  const u16* proj = (const u16*)(p.ws + OFF_P);
  u16* xs = (u16*)(p.ws + OFF_XS); u16* Bm = (u16*)(p.ws + OFF_BM); u16* Cm = (u16*)(p.ws + OFF_CM);
  u16* rr = (u16*)(p.ws + OFF_R); u16* kk_ = (u16*)(p.ws + OFF_K); u16* vv = (u16*)(p.ws + OFF_V); u16* sz = (u16*)(p.ws + OFF_SZ);
  u16* alora = (u16*)(p.ws + OFF_S);
  float* dt = (float*)(p.ws + OFF_DT); float* invn = (float*)(p.ws + OFF_INVN);
  const float* cw = p.in[ICONVW] + (size_t)l * 5 * 1024;
  const float* cb = p.in[ICONVB] + (size_t)l * 1024;
  const float* mu = p.in[IMU] + (size_t)l * 1792;
  const float* kkc = p.in[IKK] + (size_t)l * 512;
  const float* dtb = p.in[IDTB] + (size_t)l * 16;
  for (int tok = c.bid * 8 + wave; tok < MTOK; tok += c.nb * 8) {
    const int ts = tok & (SEQ - 1);
    const u16* prow = proj + (size_t)tok * NPROJ;
#pragma unroll
    for (int i = 0; i < 8; ++i) {
      int c = 2 * lane + 128 * i;
      float a0 = cb[c], a1 = cb[c + 1];
#pragma unroll
      for (int j = 0; j < 5; ++j) {
        int tt = ts + j - 2;
        if (tt >= 0 && tt < SEQ) {
          u32 w = *(const u32*)(prow + (long)(j - 2) * NPROJ + 512 + c);
          a0 += cw[j * 1024 + c] * bflo(w); a1 += cw[j * 1024 + c + 1] * bfhi(w);
        }
      }
      u32 o = pack2(siluf_(a0), siluf_(a1));
      if (c < 512) *(u32*)(xs + (size_t)tok * 512 + c) = o;
      else if (c < 768) *(u32*)(Bm + (size_t)tok * 256 + (c - 512)) = o;
      else *(u32*)(Cm + (size_t)tok * 256 + (c - 768)) = o;
    }
    if (lane < 16) { float x = dt[(size_t)tok * 16 + lane] + dtb[lane]; dt[(size_t)tok * 16 + lane] = softplusf_(x); }
#pragma unroll
    for (int i = 0; i < 4; ++i) {
      int c = 2 * lane + 128 * i;
      u32 w = *(const u32*)(prow + c);
      *(u32*)(sz + (size_t)tok * 512 + c) = pack2(siluf_(bflo(w)), siluf_(bfhi(w)));
    }
#pragma unroll
    for (int i = 0; i < 14; ++i) {
      int c = 2 * lane + 128 * i;
      u32 w0 = *(const u32*)(prow + SSD_COLS + c);
      u32 wm = (ts > 0) ? *(const u32*)(prow - NPROJ + SSD_COLS + c) : 0u;
      u32 wp = (ts < SEQ - 1) ? *(const u32*)(prow + NPROJ + SSD_COLS + c) : 0u;
      float p0 = bflo(w0), p1 = bfhi(w0);
      float u0 = p0 + (0.5f * (bflo(wm) + bflo(wp)) - p0) * mu[c];
      float u1 = p1 + (0.5f * (bfhi(wm) + bfhi(wp)) - p1) * mu[c + 1];
      if (i < 4) { *(u32*)(rr + (size_t)tok * 512 + c) = pack2(u0, u1); }
      else if (i < 8) {
        int ck = c - 512;
        u32 o = pack2(u0, u1);
        *(u32*)(kk_ + (size_t)tok * 512 + ck) = o;
        float q0 = bflo(o) * kkc[ck], q1 = bfhi(o) * kkc[ck + 1];
        float ss = q0 * q0 + q1 * q1;
#pragma unroll
        for (int off = 16; off >= 1; off >>= 1) ss += __shfl_xor(ss, off);
        if ((lane & 31) == 0) invn[(size_t)tok * 8 + 2 * (i - 4) + (lane >> 5)] = 1.f / fmaxf(sqrtf(ss), 1e-12f);
      }
      else if (i < 12) { *(u32*)(vv + (size_t)tok * 512 + (c - 1024)) = pack2(u0, u1); }
      else if (i == 12) {
        float o0, o1;
        if (lane < 32) { o0 = tanhf(u0); o1 = tanhf(u1); } else { o0 = u0; o1 = u1; }
        *(u32*)(alora + (size_t)tok * 256 + (c - 1536)) = pack2(o0, o1);
      } else {
        *(u32*)(alora + (size_t)tok * 256 + (c - 1536)) = pack2(sigmoidf_(u0), sigmoidf_(u1));
      }
    }
  }
}

__device__ __forceinline__ float rowsum4(float x) {
  auto r = __builtin_amdgcn_permlane16_swap(__float_as_uint(x), __float_as_uint(x), false, false);
  float y = __uint_as_float(r[0]) + __uint_as_float(r[1]);
  auto r2 = __builtin_amdgcn_permlane32_swap(__float_as_uint(y), __float_as_uint(y), false, false);
  return __uint_as_float(r2[0]) + __uint_as_float(r2[1]);
}

#define DPPB(I) " row_newbcast:" #I " row_mask:0xf bank_mask:0xf\n"

__device__ __forceinline__ float dot16(const float (&S)[16], float vec) {
  float acc;
  asm volatile("s_nop 1\n"
      "v_mul_f32_dpp %0, %17, %1" DPPB(0)
      "v_fmac_f32_dpp %0, %17, %2" DPPB(1)
      "v_fmac_f32_dpp %0, %17, %3" DPPB(2)
      "v_fmac_f32_dpp %0, %17, %4" DPPB(3)
      "v_fmac_f32_dpp %0, %17, %5" DPPB(4)
      "v_fmac_f32_dpp %0, %17, %6" DPPB(5)
      "v_fmac_f32_dpp %0, %17, %7" DPPB(6)
      "v_fmac_f32_dpp %0, %17, %8" DPPB(7)
      "v_fmac_f32_dpp %0, %17, %9" DPPB(8)
      "v_fmac_f32_dpp %0, %17, %10" DPPB(9)
      "v_fmac_f32_dpp %0, %17, %11" DPPB(10)
      "v_fmac_f32_dpp %0, %17, %12" DPPB(11)
      "v_fmac_f32_dpp %0, %17, %13" DPPB(12)
      "v_fmac_f32_dpp %0, %17, %14" DPPB(13)
      "v_fmac_f32_dpp %0, %17, %15" DPPB(14)
      "v_fmac_f32_dpp %0, %17, %16" DPPB(15)
      : "=&v"(acc)
      : "v"(S[0]), "v"(S[1]), "v"(S[2]), "v"(S[3]), "v"(S[4]), "v"(S[5]), "v"(S[6]), "v"(S[7]),
        "v"(S[8]), "v"(S[9]), "v"(S[10]), "v"(S[11]), "v"(S[12]), "v"(S[13]), "v"(S[14]), "v"(S[15]), "v"(vec));
  return acc;
}

#define UPD(I, SI) \
      "v_mul_f32_dpp " SI ", %16, " SI DPPB(I) \
      "v_fmac_f32_dpp " SI ", %17, %19" DPPB(I) \
      "v_fmac_f32_dpp " SI ", %18, %20" DPPB(I)
__device__ __forceinline__ void update16(float (&S)[16], float w, float b, float kd, float nskk, float vv) {
  asm volatile("s_nop 1\n"
      UPD(0, "%0") UPD(1, "%1") UPD(2, "%2") UPD(3, "%3") UPD(4, "%4") UPD(5, "%5") UPD(6, "%6") UPD(7, "%7")
      UPD(8, "%8") UPD(9, "%9") UPD(10, "%10") UPD(11, "%11") UPD(12, "%12") UPD(13, "%13") UPD(14, "%14") UPD(15, "%15")
      : "+v"(S[0]), "+v"(S[1]), "+v"(S[2]), "+v"(S[3]), "+v"(S[4]), "+v"(S[5]), "+v"(S[6]), "+v"(S[7]),
        "+v"(S[8]), "+v"(S[9]), "+v"(S[10]), "+v"(S[11]), "+v"(S[12]), "+v"(S[13]), "+v"(S[14]), "+v"(S[15])
      : "v"(w), "v"(b), "v"(kd), "v"(nskk), "v"(vv));
}

constexpr int PF = 8;

__device__ void rwkv_scan(const Params& p, int l, int item, int tid  ) {
  const int d = item >> 7, b = (item >> 3) & 15, h = item & 7;
  const int j = tid >> 6, lane = tid & 63, vl = lane & 15;
  const u16* rr = (const u16*)(p.ws + OFF_R); const u16* kk_ = (const u16*)(p.ws + OFF_K); const u16* vv_ = (const u16*)(p.ws + OFF_V);
  const u16* ee = (const u16*)(p.ws + OFF_E) + (size_t)d * MTOK * 512;
  const u16* aa = (const u16*)(p.ws + OFF_A) + (size_t)d * MTOK * 512;
  const float* invn = (const float*)(p.ws + OFF_INVN);
  u16* yr = (u16*)(p.ws + OFF_YR) + (size_t)d * MTOK * 512;
  const int ch = h * 64 + lane, chv = h * 64 + 16 * j + vl;
  const float kkc = p.in[IKK][(size_t)l * 512 + ch];
  const float ka = p.in[IKA][(size_t)l * 512 + ch];
  const long tok0 = (long)b * SEQ + (d ? SEQ - 1 : 0);
  const long dstep = d ? -1 : 1;
  float S[16];
#pragma unroll
  for (int i = 0; i < 16; ++i) S[i] = 0.f;

  u16 cr[PF], ck[PF], ce[PF], ca[PF], cv[PF]; float ci[PF];
  u16 nr[PF], nk[PF], ne[PF], na[PF], nv[PF]; float ni[PF];
#pragma unroll
  for (int s = 0; s < PF; ++s) {
    long tok = tok0 + dstep * s;
    cr[s] = rr[tok * 512 + ch]; ck[s] = kk_[tok * 512 + ch]; ce[s] = ee[tok * 512 + ch]; ca[s] = aa[tok * 512 + ch];
    cv[s] = vv_[tok * 512 + chv]; ci[s] = invn[tok * 8 + h];
  }
  for (int t = 0; t < SEQ; t += PF) {
    const long tokb = tok0 + dstep * t;
    if (t + PF < SEQ) {
#pragma unroll
      for (int s = 0; s < PF; ++s) {
        long tok = tokb + dstep * (PF + s);
        nr[s] = rr[tok * 512 + ch]; nk[s] = kk_[tok * 512 + ch]; ne[s] = ee[tok * 512 + ch]; na[s] = aa[tok * 512 + ch];
        nv[s] = vv_[tok * 512 + chv]; ni[s] = invn[tok * 8 + h];
      }
    }
#pragma unroll
    for (int s = 0; s < PF; ++s) {
      float r = bf2f(cr[s]), k = bf2f(ck[s]), e = bf2f(ce[s]), a = bf2f(ca[s]), vrow = bf2f(cv[s]);
      float w = __expf(-e);
      float kkv = k * kkc * ci[s];
      float bv = kkv * a;
      float kd = k * (1.f + (a - 1.f) * ka);
      float pdot = dot16(S, kkv);
      float nskk = -rowsum4(pdot);
      update16(S, w, bv, kd, nskk, vrow);
      float y = rowsum4(dot16(S, r));
      if (lane < 16) yr[(tokb + dstep * s) * 512 + chv] = f2bf(y);
    }
#pragma unroll
    for (int s = 0; s < PF; ++s) { cr[s] = nr[s]; ck[s] = nk[s]; ce[s] = ne[s]; ca[s] = na[s]; cv[s] = nv[s]; ci[s] = ni[s]; }
  }
}

__device__ __forceinline__ void group_barrier(int* cnt, int& gen, int lane) {
  __builtin_amdgcn_fence(__ATOMIC_RELEASE, "workgroup");
  gen += 4;
  if (lane == 0) __hip_atomic_fetch_add(cnt, 1, __ATOMIC_RELAXED, __HIP_MEMORY_SCOPE_WORKGROUP);
  while (__hip_atomic_load(cnt, __ATOMIC_RELAXED, __HIP_MEMORY_SCOPE_WORKGROUP) < gen) __builtin_amdgcn_s_sleep(1);
  __builtin_amdgcn_fence(__ATOMIC_ACQUIRE, "workgroup");
}

constexpr int LC = 64;
constexpr int ST128 = 136, ST64 = 72;
constexpr int SSD_SC = 0, SSD_SB = 17408, SSD_SBT = 34816, SSD_SXT = 53248, SSD_SM = 62464, SSD_SH = 71680, SSD_CNT = 89088;

__device__ void ssd_item(const Params& p, int l, int item, int tid  , char* shm, int& gen) {
  const int d = item >> 7, b = (item >> 3) & 15, h = item & 7, g = h >> 2;
  const int w4 = tid >> 6, lane = tid & 63, wr = w4 >> 1, wc = w4 & 1, l31 = lane & 31, hi = lane >> 5;
  u16* sC = (u16*)(shm + SSD_SC); u16* sB = (u16*)(shm + SSD_SB); u16* sBT = (u16*)(shm + SSD_SBT);
  u16* sXT = (u16*)(shm + SSD_SXT); u16* sM = (u16*)(shm + SSD_SM); u16* sH = (u16*)(shm + SSD_SH);
  int* cnt = (int*)(shm + SSD_CNT);
  const u16* xs = (const u16*)(p.ws + OFF_XS); const u16* Bm = (const u16*)(p.ws + OFF_BM); const u16* Cm = (const u16*)(p.ws + OFF_CM);
  const float* dt = (const float*)(p.ws + OFF_DT);
  u16* ys = (u16*)(p.ws + OFF_S) + (size_t)d * MTOK * 512;
  const float Aneg = -__expf(p.in[IALOG][l * 16 + d * 8 + h]);
  for (int i = tid; i < 64 * ST128 / 2; i += 256) ((u32*)sH)[i] = 0u;
  f32x16 Hacc[2];
#pragma unroll
  for (int i = 0; i < 16; ++i) { Hacc[0][i] = 0.f; Hacc[1][i] = 0.f; }

  for (int ci = 0; ci < SEQ / LC; ++ci) {
    const int c = d ? (SEQ / LC - 1 - ci) : ci;
    const long tokbase = (long)b * SEQ + c * LC;
#define TOK(lr) (tokbase + (d ? (LC - 1 - (lr)) : (lr)))
    const float dtv = dt[TOK(lane) * 16 + d * 8 + h];
    float cs = dtv * Aneg;
#pragma unroll
    for (int o = 1; o < 64; o <<= 1) { float t = __shfl_up(cs, o); if (lane >= o) cs += t; }
    const float cs_last = __shfl(cs, 63);
#pragma unroll
    for (int i = 0; i < 4; ++i) {
      int idx = tid + 256 * i, row = idx >> 4, seg = idx & 15;
      long tk = TOK(row);
      uint4 cvv = *(const uint4*)(Cm + tk * 256 + g * 128 + seg * 8);
      uint4 bvv = *(const uint4*)(Bm + tk * 256 + g * 128 + seg * 8);
      *(uint4*)(sC + row * ST128 + seg * 8) = cvv;
      *(uint4*)(sB + row * ST128 + seg * 8) = bvv;
      float dec = __expf(cs_last - __shfl(cs, row));
      u32 bw[4] = {bvv.x, bvv.y, bvv.z, bvv.w};
#pragma unroll
      for (int q = 0; q < 4; ++q) {
        sBT[(seg * 8 + 2 * q) * ST64 + row] = f2bf(bflo(bw[q]) * dec);
        sBT[(seg * 8 + 2 * q + 1) * ST64 + row] = f2bf(bfhi(bw[q]) * dec);
      }
    }
#pragma unroll
    for (int i = 0; i < 2; ++i) {
      int idx = tid + 256 * i, row = idx >> 3, seg = idx & 7;
      long tk = TOK(row);
      uint4 xv = *(const uint4*)(xs + tk * 512 + h * 64 + seg * 8);
      float dts = __shfl(dtv, row);
      u32 xw[4] = {xv.x, xv.y, xv.z, xv.w};
#pragma unroll
      for (int q = 0; q < 4; ++q) {
        sXT[(seg * 8 + 2 * q) * ST64 + row] = f2bf(bflo(xw[q]) * dts);
        sXT[(seg * 8 + 2 * q + 1) * ST64 + row] = f2bf(bfhi(xw[q]) * dts);
      }
    }
    group_barrier(cnt, gen, lane);
    {
      f32x16 acc;
#pragma unroll
      for (int i = 0; i < 16; ++i) acc[i] = 0.f;
#pragma unroll
      for (int kb = 0; kb < 8; ++kb) {
        bf16x8 a = *(const bf16x8*)(sC + (32 * wr + l31) * ST128 + kb * 16 + hi * 8);
        bf16x8 bb = *(const bf16x8*)(sB + (32 * wc + l31) * ST128 + kb * 16 + hi * 8);
        acc = __builtin_amdgcn_mfma_f32_32x32x16_bf16(a, bb, acc, 0, 0, 0);
      }
      const int s = 32 * wc + l31;
      const float cs_s = __shfl(cs, s);
#pragma unroll
      for (int i = 0; i < 16; ++i) {
        int lrow = 32 * wr + 8 * (i >> 2) + 4 * hi + (i & 3);
        float cs_l = __shfl(cs, lrow);
        float m = (s <= lrow) ? acc[i] * __expf(cs_l - cs_s) : 0.f;
        sM[lrow * ST64 + s] = f2bf(m);
      }
    }
    group_barrier(cnt, gen, lane);
    {
      f32x16 acc1, acc2;
#pragma unroll
      for (int i = 0; i < 16; ++i) { acc1[i] = 0.f; acc2[i] = 0.f; }
#pragma unroll
      for (int kb = 0; kb < 4; ++kb) {
        bf16x8 a = *(const bf16x8*)(sM + (32 * wr + l31) * ST64 + kb * 16 + hi * 8);
        bf16x8 bb = *(const bf16x8*)(sXT + (32 * wc + l31) * ST64 + kb * 16 + hi * 8);
        acc1 = __builtin_amdgcn_mfma_f32_32x32x16_bf16(a, bb, acc1, 0, 0, 0);
      }
#pragma unroll
      for (int kb = 0; kb < 8; ++kb) {
        bf16x8 a = *(const bf16x8*)(sC + (32 * wr + l31) * ST128 + kb * 16 + hi * 8);
        bf16x8 bb = *(const bf16x8*)(sH + (32 * wc + l31) * ST128 + kb * 16 + hi * 8);
        acc2 = __builtin_amdgcn_mfma_f32_32x32x16_bf16(a, bb, acc2, 0, 0, 0);
      }
      const int pcol = h * 64 + 32 * wc + l31;
#pragma unroll
      for (int i = 0; i < 16; ++i) {
        int lrow = 32 * wr + 8 * (i >> 2) + 4 * hi + (i & 3);
        float y = acc1[i] + __expf(__shfl(cs, lrow)) * acc2[i];
        ys[TOK(lrow) * 512 + pcol] = f2bf(y);
      }
    }
    group_barrier(cnt, gen, lane);
    {
      const float dall = __expf(cs_last);
#pragma unroll
      for (int nt = 0; nt < 2; ++nt) {
#pragma unroll
        for (int i = 0; i < 16; ++i) Hacc[nt][i] *= dall;
#pragma unroll
        for (int kb = 0; kb < 4; ++kb) {
          bf16x8 a = *(const bf16x8*)(sXT + (32 * wr + l31) * ST64 + kb * 16 + hi * 8);
          bf16x8 bb = *(const bf16x8*)(sBT + (64 * wc + 32 * nt + l31) * ST64 + kb * 16 + hi * 8);
          Hacc[nt] = __builtin_amdgcn_mfma_f32_32x32x16_bf16(a, bb, Hacc[nt], 0, 0, 0);
        }
#pragma unroll
        for (int i = 0; i < 16; ++i) {
          int prow = 32 * wr + 8 * (i >> 2) + 4 * hi + (i & 3);
          sH[prow * ST128 + 64 * wc + 32 * nt + l31] = f2bf(Hacc[nt][i]);
        }
      }
    }
    group_barrier(cnt, gen, lane);
#undef TOK
  }
}

__device__ void mixer_phase(const Ctx c, const Params& p, int l, char* shm) {
  int* cnt = (int*)(shm + SSD_CNT);
  if (c.tid == 0) *cnt = 0;
  __syncthreads();
  int gen = 0;
  if (c.tid < 256) {
    for (int it = c.bid; it < 256; it += c.nb) rwkv_scan(p, l, it, c.tid);
  } else {
    for (int it = c.bid; it < 256; it += c.nb) ssd_item(p, l, it, c.tid - 256, shm, gen);
  }
}

__device__ void post_phase(const Ctx c, const Params& p, int l) {
  const int wave = c.tid >> 6, lane = c.tid & 63;
  const u16* xs = (const u16*)(p.ws + OFF_XS); const u16* sz = (const u16*)(p.ws + OFF_SZ);
  const u16* ys = (const u16*)(p.ws + OFF_S);
  const u16* yr = (const u16*)(p.ws + OFF_YR);
  const u16* rr = (const u16*)(p.ws + OFF_R); const u16* kk_ = (const u16*)(p.ws + OFF_K); const u16* vv = (const u16*)(p.ws + OFF_V);
  const u16* aa = (const u16*)(p.ws + OFF_A); const u16* gg = (const u16*)(p.ws + OFF_G);
  u16* ymix = (u16*)(p.ws + OFF_YMIX);
  const float* dskip = p.in[IDSKIP] + l * 8;
  const float* ng = p.in[ISSDG] + (size_t)l * 512;
  const float* ka = p.in[IKA] + (size_t)l * 512; const float* rk = p.in[IRK] + (size_t)l * 512;
  const float* lg = p.in[ILNXG] + (size_t)l * 512; const float* lb = p.in[ILNXB] + (size_t)l * 512;
  const int c0 = lane * 8;
  for (int tok = c.bid * 8 + wave; tok < MTOK; tok += c.nb * 8) {
    const size_t o = (size_t)tok * 512 + c0;
    {
      uint4 f = *(const uint4*)(ys + o), bk = *(const uint4*)(ys + (size_t)MTOK * 512 + o);
      uint4 x = *(const uint4*)(xs + o), z = *(const uint4*)(sz + o);
      u32 fw[4] = {f.x, f.y, f.z, f.w}, bw[4] = {bk.x, bk.y, bk.z, bk.w}, xw[4] = {x.x, x.y, x.z, x.w}, zw[4] = {z.x, z.y, z.z, z.w};
      const float ds = dskip[lane >> 3];
      float y[8]; float ss = 0.f;
#pragma unroll
      for (int q = 0; q < 4; ++q) {
        y[2 * q] = (bflo(fw[q]) + bflo(bw[q]) + ds * bflo(xw[q])) * bflo(zw[q]);
        y[2 * q + 1] = (bfhi(fw[q]) + bfhi(bw[q]) + ds * bfhi(xw[q])) * bfhi(zw[q]);
        ss += y[2 * q] * y[2 * q] + y[2 * q + 1] * y[2 * q + 1];
      }
#pragma unroll
      for (int off = 16; off >= 1; off >>= 1) ss += __shfl_xor(ss, off);
      const float rs = rsqrtf(ss * (1.f / 256.f) + RMS_EPS);
      uint4 ov;
      ov.x = pack2(y[0] * rs * ng[c0 + 0], y[1] * rs * ng[c0 + 1]);
      ov.y = pack2(y[2] * rs * ng[c0 + 2], y[3] * rs * ng[c0 + 3]);
      ov.z = pack2(y[4] * rs * ng[c0 + 4], y[5] * rs * ng[c0 + 5]);
      ov.w = pack2(y[6] * rs * ng[c0 + 6], y[7] * rs * ng[c0 + 7]);
      *(uint4*)(ymix + (size_t)tok * 1024 + c0) = ov;
    }
    {
      uint4 f = *(const uint4*)(yr + o), bk = *(const uint4*)(yr + (size_t)MTOK * 512 + o);
      uint4 r4 = *(const uint4*)(rr + o), k4 = *(const uint4*)(kk_ + o), v4 = *(const uint4*)(vv + o), g4 = *(const uint4*)(gg + o);
      uint4 af4 = *(const uint4*)(aa + o), ab4 = *(const uint4*)(aa + (size_t)MTOK * 512 + o);
      u32 fw[4] = {f.x, f.y, f.z, f.w}, bw[4] = {bk.x, bk.y, bk.z, bk.w};
      u32 rw[4] = {r4.x, r4.y, r4.z, r4.w}, kw[4] = {k4.x, k4.y, k4.z, k4.w}, vw[4] = {v4.x, v4.y, v4.z, v4.w}, gw[4] = {g4.x, g4.y, g4.z, g4.w};
      u32 afw[4] = {af4.x, af4.y, af4.z, af4.w}, abw[4] = {ab4.x, ab4.y, ab4.z, ab4.w};
      float y[8], vf[8], gf[8]; float sum = 0.f, bon = 0.f;
#pragma unroll
      for (int q = 0; q < 4; ++q) {
#pragma unroll
        for (int e = 0; e < 2; ++e) {
          int c = c0 + 2 * q + e;
          float yf = e ? bfhi(fw[q]) : bflo(fw[q]), yb = e ? bfhi(bw[q]) : bflo(bw[q]);
          float r = e ? bfhi(rw[q]) : bflo(rw[q]), k = e ? bfhi(kw[q]) : bflo(kw[q]);
          float af = e ? bfhi(afw[q]) : bflo(afw[q]), ab = e ? bfhi(abw[q]) : bflo(abw[q]);
          y[2 * q + e] = yf + yb; sum += yf + yb;
          vf[2 * q + e] = e ? bfhi(vw[q]) : bflo(vw[q]);
          gf[2 * q + e] = e ? bfhi(gw[q]) : bflo(gw[q]);
          bon += r * k * rk[c] * (2.f + (af + ab - 2.f) * ka[c]);
        }
      }
#pragma unroll
      for (int off = 4; off >= 1; off >>= 1) { sum += __shfl_xor(sum, off); bon += __shfl_xor(bon, off); }
      const float mean = sum * (1.f / 64.f);
      float sq = 0.f;
#pragma unroll
      for (int q = 0; q < 8; ++q) { float dlt = y[q] - mean; sq += dlt * dlt; }
#pragma unroll
      for (int off = 4; off >= 1; off >>= 1) sq += __shfl_xor(sq, off);
      const float rstd = rsqrtf(sq * (1.f / 64.f) + GN_EPS);
      float ovf[8];
#pragma unroll
      for (int q = 0; q < 8; ++q) ovf[q] = ((y[q] - mean) * rstd * lg[c0 + q] + lb[c0 + q] + bon * vf[q]) * gf[q];
      uint4 ov;
      ov.x = pack2(ovf[0], ovf[1]); ov.y = pack2(ovf[2], ovf[3]); ov.z = pack2(ovf[4], ovf[5]); ov.w = pack2(ovf[6], ovf[7]);
      *(uint4*)(ymix + (size_t)tok * 1024 + 512 + c0) = ov;
    }
  }
}

constexpr int NPHASE = 21;

__device__ __forceinline__ void run_phase(const Ctx c, const Params& p, int ph, char* shm) {
  const int l = (ph == 0) ? 0 : (ph - 1) / 10, s = (ph == 0) ? -1 : (ph - 1) % 10;
  if (s == 0 || s == 2 || s == 5 || s == 7 || s == 8) {
    GemmDesc gd{};
    gd.eproj = EpiProj{(u16*)(p.ws + OFF_P), (float*)(p.ws + OFF_DT)};
    gd.elora = EpiLora{(u16*)(p.ws + OFF_E), (u16*)(p.ws + OFF_A), (u16*)(p.ws + OFF_G), p.in[IW0] + (size_t)l * 1024, p.in[IA0] + (size_t)l * 1024};
    gd.eres = EpiResid{(float*)(p.ws + OFF_PRE), p.out};
    gd.erelu = EpiRelu2{(u16*)(p.ws + OFF_ACT)};
    if (s == 0)      { gd.A = (const u16*)(p.ws + OFF_H);    gd.Bt = (const u16*)(p.ws + OFF_WIN);   gd.N = NPROJ; gd.K = DM;  gd.kind = 0; }
    else if (s == 2) { gd.A = (const u16*)(p.ws + OFF_S);    gd.Bt = (const u16*)(p.ws + OFF_WLORA); gd.N = 2560;  gd.K = 256; gd.kind = 1; }
    else if (s == 5) { gd.A = (const u16*)(p.ws + OFF_YMIX); gd.Bt = (const u16*)(p.ws + OFF_WOUT);  gd.N = DM;    gd.K = DM;  gd.kind = 2; }
    else if (s == 7) { gd.A = (const u16*)(p.ws + OFF_H);    gd.Bt = (const u16*)(p.ws + OFF_WFC);   gd.N = DFF;   gd.K = DM;  gd.kind = 3; }
    else             { gd.A = (const u16*)(p.ws + OFF_ACT);  gd.Bt = (const u16*)(p.ws + OFF_WPROJ); gd.N = DM;    gd.K = DFF; gd.kind = 2; }
    gemm_phase(c, gd, shm);
    return;
  }
  switch (s) {
    case -1:
      ln_phase(c, p.in[IX], p.in[ILN0G], p.in[ILN0B], p.out, (u16*)(p.ws + OFF_H));
      convert_weights(c, p, 0, shm);
      break;
    case 1: prep_phase(c, p, l); break;
    case 3: mixer_phase(c, p, l, shm); break;
    case 4: post_phase(c, p, l); break;
    case 6: ln_phase(c, (const float*)(p.ws + OFF_PRE), p.in[ILN1G] + (size_t)l * DM, p.in[ILN1B] + (size_t)l * DM, p.out, (u16*)(p.ws + OFF_H)); break;
    case 9:
      ln_phase(c, (const float*)(p.ws + OFF_PRE), p.in[ILN2G] + (size_t)l * DM, p.in[ILN2B] + (size_t)l * DM, p.out, (u16*)(p.ws + OFF_H));
      if (l == 0) convert_weights(c, p, 1, shm);
      break;
    default: break;
  }
}

__global__ void __launch_bounds__(512) mega(Params p, int lo, int hi) {
  extern __shared__ __attribute__((aligned(16))) char shm[];
  for (int ph = lo; ph < hi; ++ph) {
    Params q = p;
    asm volatile("" : "+s"(q.in[0]), "+s"(q.in[1]), "+s"(q.in[2]), "+s"(q.in[3]), "+s"(q.in[4]), "+s"(q.in[5]), "+s"(q.in[6]),
                      "+s"(q.in[7]), "+s"(q.in[8]), "+s"(q.in[9]), "+s"(q.in[10]), "+s"(q.in[11]), "+s"(q.in[12]), "+s"(q.in[13]));
    asm volatile("" : "+s"(q.in[14]), "+s"(q.in[15]), "+s"(q.in[16]), "+s"(q.in[17]), "+s"(q.in[18]), "+s"(q.in[19]), "+s"(q.in[20]),
                      "+s"(q.in[21]), "+s"(q.in[22]), "+s"(q.in[23]), "+s"(q.in[24]), "+s"(q.in[25]), "+s"(q.in[26]), "+s"(q.in[27]));
    Ctx c{(int)threadIdx.x, (int)blockIdx.x, (int)gridDim.x};
    asm volatile("" : "+s"(q.out), "+s"(q.ws), "+v"(c.tid), "+s"(c.bid), "+s"(c.nb));
    run_phase(c, q, ph, shm);
    if (ph + 1 < hi) { cg::this_grid().sync(); }
  }
}

extern "C" void kernel_launch(void* const* d_in, const int* in_sizes, int n_in, void* d_out, int out_size,
                              void* d_ws, size_t ws_size, hipStream_t stream) {
  if (ws_size < WS_NEED) { fprintf(stderr, "workspace too small: %zu < %zu\n", ws_size, WS_NEED); return; }
  Params p{};
  for (int i = 0; i < NIN; ++i) p.in[i] = (const float*)d_in[i];
  p.out = (float*)d_out;
  p.ws = (char*)d_ws;
  hipFuncSetAttribute((const void*)mega, hipFuncAttributeMaxDynamicSharedMemorySize, SHM_BYTES);
#if COOP
  int lo = 0, hi = NPHASE;
  void* args[] = {&p, &lo, &hi};
  hipError_t e = hipLaunchCooperativeKernel((const void*)mega, dim3(256), dim3(512), args, SHM_BYTES, stream);
  if (e != hipSuccess) fprintf(stderr, "cooperative launch failed: %s\n", hipGetErrorString(e));
#else
  for (int ph = 0; ph < NPHASE; ++ph) mega<<<dim3(256), dim3(512), SHM_BYTES, stream>>>(p, ph, ph + 1);
#endif
}
```

```cpp
#include <hip/hip_runtime.h>
#include <hip/hip_bf16.h>
#include <hip/hip_cooperative_groups.h>
#include <cstdio>
namespace cg = cooperative_groups;

#ifndef COOP
#define COOP 1
#endif
#define PROBE_MIX 0
#define PROBE_CLK 0
#define PROBE_SYNC 0
#define GEMM_REGSTAGE 0
#define PROBE_REP 0x000

typedef unsigned short u16;
typedef unsigned int u32;
using bf16x8 = __attribute__((ext_vector_type(8))) short;
using f32x4 = __attribute__((ext_vector_type(4))) float;
using f32x16 = __attribute__((ext_vector_type(16))) float;
using i32x4 = __attribute__((ext_vector_type(4))) int;

constexpr int MTOK = 32768, SEQ = 2048, DM = 1024, DFF = 4096;
constexpr int NPROJ = 3584;
constexpr int SSD_COLS = 1552;
constexpr float ALPHA = 1.4142135623730951f;
constexpr float LN_EPS = 1e-5f, RMS_EPS = 1e-5f, GN_EPS = 64e-5f;

enum { IX=0, ILN0G, ILN0B, IWIN, ICONVW, ICONVB, IDTB, IALOG, IDSKIP, ISSDG, IMU, IW0, IWUP, IA0, IAUP, IGUP,
       IKK, IKA, IRK, ILNXG, ILNXB, IWOUT, ILN1G, ILN1B, IWFC, IWPROJ, ILN2G, ILN2B, NIN };

constexpr size_t OFF_WIN = 0;
constexpr size_t OFF_WOUT = 7340032;
constexpr size_t OFF_WFC = 9437184;
constexpr size_t OFF_WPROJ = 17825792;
constexpr size_t OFF_WLORA = 26214400;
constexpr size_t OFF_H = 27525120;
constexpr size_t OFF_XS = OFF_H;
constexpr size_t OFF_BM = OFF_H + 33554432;
constexpr size_t OFF_CM = OFF_H + 50331648;
constexpr size_t OFF_P = OFF_H + 67108864;
constexpr size_t OFF_E = OFF_P;
constexpr size_t OFF_A = OFF_P + 67108864;
constexpr size_t OFF_G = OFF_P + 134217728;
constexpr size_t OFF_YR = OFF_P + 167772160;
constexpr size_t OFF_YMIX = OFF_P;
constexpr size_t OFF_ACT = OFF_P;
constexpr size_t OFF_S = OFF_P + 234881024;
constexpr size_t OFF_Q = OFF_S + 67108864;
constexpr size_t OFF_R = OFF_Q;
constexpr size_t OFF_K = OFF_Q + 33554432;
constexpr size_t OFF_V = OFF_Q + 67108864;
constexpr size_t OFF_SZ = OFF_Q + 100663296;
constexpr size_t OFF_PRE = OFF_Q;
constexpr size_t OFF_SM = OFF_Q + 134217728;
constexpr size_t OFF_DT = OFF_SM;
constexpr size_t OFF_INVN = OFF_SM + 2097152;
constexpr size_t OFF_DTRAW = OFF_S + 50331648;
constexpr size_t OFF_BAR = OFF_SM + 4194304;
constexpr size_t WS_NEED = OFF_BAR + 16384;

struct Params {
  const float* in[NIN];
  float* out;
  char* ws;
};
struct Ctx { int tid, bid, nb; };
__device__ __forceinline__ int lane_id_() { int l; asm volatile("v_mbcnt_lo_u32_b32 %0, -1, 0\n\tv_mbcnt_hi_u32_b32 %0, -1, %0" : "=v"(l)); return l; }
struct PV {
  const Params& pr; long z;
  __device__ __forceinline__ const float* in(int i) const { return pr.in[i] + z; }
  __device__ __forceinline__ char* ws() const { return pr.ws + z; }
  __device__ __forceinline__ float* out() const { return pr.out + z; }
};

__device__ __forceinline__ u16 f2bf(float f) {
  u32 u = __float_as_uint(f);
  u += 0x7fffu + ((u >> 16) & 1u);
  return (u16)(u >> 16);
}
__device__ __forceinline__ float bf2f(u16 h) { return __uint_as_float(((u32)h) << 16); }
__device__ __forceinline__ float bflo(u32 w) { return __uint_as_float(w << 16); }
__device__ __forceinline__ float bfhi(u32 w) { return __uint_as_float(w & 0xffff0000u); }
__device__ __forceinline__ u32 pack2(float a, float b) { return (u32)f2bf(a) | ((u32)f2bf(b) << 16); }
__device__ __forceinline__ float sigmoidf_(float x) { return __builtin_amdgcn_rcpf(1.f + __expf(-x)); }
__device__ __forceinline__ float siluf_(float x) { return x * __builtin_amdgcn_rcpf(1.f + __expf(-x)); }
__device__ __forceinline__ float tanhf_(float x) { return 1.f - 2.f * __builtin_amdgcn_rcpf(1.f + __expf(2.f * x)); }
__device__ __forceinline__ float softplusf_(float x) { return fmaxf(x, 0.f) + log1pf(__expf(-fabsf(x))); }
__device__ __forceinline__ uint4 ldnt16(const void* p) {
  i32x4 v = __builtin_nontemporal_load((const i32x4*)p);
  return make_uint4((u32)v[0], (u32)v[1], (u32)v[2], (u32)v[3]);
}
__device__ __forceinline__ float4 ldnt16f(const void* p) {
  uint4 v = ldnt16(p);
  return make_float4(__uint_as_float(v.x), __uint_as_float(v.y), __uint_as_float(v.z), __uint_as_float(v.w));
}
__device__ __forceinline__ float wave_sum(float v) {
#pragma unroll
  for (int o = 32; o >= 1; o >>= 1) v += __shfl_xor(v, o);
  return v;
}

__device__ __forceinline__ uint4 pack8v(f32x4 a, f32x4 b) {
  uint4 o; o.x = pack2(a[0], a[1]); o.y = pack2(a[2], a[3]); o.z = pack2(b[0], b[1]); o.w = pack2(b[2], b[3]);
  return o;
}
struct EpiProj {
  u16* proj; float* dt;
  __device__ __forceinline__ void operator()(int row, int col, f32x4 v, f32x4 w) const {
    *(uint4*)(proj + (size_t)row * NPROJ + col) = pack8v(v, w);
    if (col >= 1536 && col < 1552) { f32x4* d = (f32x4*)(dt + (size_t)row * 16 + (col - 1536)); d[0] = v; d[1] = w; }
  }
};
struct EpiLora {
  u16* e; u16* a; u16* g; const float* w0; const float* a0;
  __device__ __forceinline__ void operator()(int row, int col, f32x4 v, f32x4 w) const {
    if (col < 1024) {
      int d = col >> 9, c = col & 511;
      f32x4 b0 = *(const f32x4*)(w0 + col), b1 = *(const f32x4*)(w0 + col + 4);
      f32x4 o0, o1;
#pragma unroll
      for (int j = 0; j < 4; ++j) { o0[j] = 0.6065306597126334f * sigmoidf_(b0[j] + v[j]); o1[j] = 0.6065306597126334f * sigmoidf_(b1[j] + w[j]); }
      *(uint4*)(e + ((size_t)d * MTOK + row) * 512 + c) = pack8v(o0, o1);
    } else if (col < 2048) {
      int cc = col - 1024, d = cc >> 9, c = cc & 511;
      f32x4 b0 = *(const f32x4*)(a0 + cc), b1 = *(const f32x4*)(a0 + cc + 4);
      f32x4 o0, o1;
#pragma unroll
      for (int j = 0; j < 4; ++j) { o0[j] = sigmoidf_(b0[j] + v[j]); o1[j] = sigmoidf_(b1[j] + w[j]); }
      *(uint4*)(a + ((size_t)d * MTOK + row) * 512 + c) = pack8v(o0, o1);
    } else {
      *(uint4*)(g + (size_t)row * 512 + (col - 2048)) = pack8v(v, w);
    }
  }
};
struct EpiResid {
  u16* pre; const float* h;
  __device__ __forceinline__ void operator()(int row, int col, f32x4 v, f32x4 w) const {
    size_t o = (size_t)row * DM + col;
    f32x4 h0 = *(const f32x4*)(h + o), h1 = *(const f32x4*)(h + o + 4);
    *(uint4*)(pre + o) = pack8v(h0 * ALPHA + v, h1 * ALPHA + w);
  }
};
struct EpiResidB {
  u16* pre; const u16* hb;
  __device__ __forceinline__ void operator()(int row, int col, f32x4 v, f32x4 w) const {
    size_t o = (size_t)row * DM + col;
    uint4 hv = ldnt16(hb + o);
    f32x4 h0 = f32x4{bflo(hv.x), bfhi(hv.x), bflo(hv.y), bfhi(hv.y)}, h1 = f32x4{bflo(hv.z), bfhi(hv.z), bflo(hv.w), bfhi(hv.w)};
    *(uint4*)(pre + o) = pack8v(h0 * ALPHA + v, h1 * ALPHA + w);
  }
};
struct EpiRelu2 {
  u16* act;
  __device__ __forceinline__ void operator()(int row, int col, f32x4 v, f32x4 w) const {
    f32x4 r0, r1;
#pragma unroll
    for (int j = 0; j < 4; ++j) { float a = fmaxf(v[j], 0.f), b = fmaxf(w[j], 0.f); r0[j] = a * a; r1[j] = b * b; }
    *(uint4*)(act + (size_t)row * DFF + col) = pack8v(r0, r1);
  }
};

constexpr int BM = 256, BN = 256, BK = 64, NXCD = 8, WGM = 8;
constexpr int SHM_BYTES = 147520;

__device__ __forceinline__ int lds_byte(int r, int c) {
  int st = (r >> 4) * 2 + (c >> 5), rr = r & 15, cc = c & 31, ob = rr * 64 + cc * 2;
  return st * 1024 + (ob ^ (((ob >> 9) & 1) << 5));
}
__device__ __forceinline__ void stage_rc(int b, int& R, int& C) {
  int st = b / 1024, sb = b % 1024, swz = sb ^ (((sb >> 9) & 1) << 5);
  R = (st >> 1) * 16 + swz / 64; C = (st & 1) * 32 + (swz % 64) / 2;
}

struct GemmDesc {
  const u16* A; const u16* Bt; int N, K, kind;
  EpiProj eproj; EpiLora elora; EpiResidB eresh; EpiResidB eresb; EpiRelu2 erelu;
};

__device__ __forceinline__ void gemm_phase(const Ctx c, const GemmDesc& gd, char* shm) {
  const u16* __restrict__ A = gd.A; const u16* __restrict__ Bt = gd.Bt;
  const int M = MTOK, N = gd.N, K = gd.K;
  constexpr int TILE_A = BM * BK * 2, TILE_B = BN * BK * 2, GLA = TILE_A / 8192, GLB = TILE_B / 8192, STAGE_B = TILE_A + TILE_B;
#define SA(b) (shm + (b) * STAGE_B)
#define SB(b) (shm + (b) * STAGE_B + TILE_A)
#define WAIT_V(n) asm volatile("s_waitcnt vmcnt(%0)" ::"n"(n) : "memory")
#define SCHED() __builtin_amdgcn_sched_barrier(0)
#define RAW_BARRIER() do { asm volatile("s_waitcnt lgkmcnt(0)" ::: "memory"); __builtin_amdgcn_s_barrier(); } while (0)
  const int nM = M / BM, nN = N / BN, nwg = nM * nN;
  const int tid = c.tid, wid = tid >> 6, lane = tid & 63, wr = wid >> 2, wc = wid & 3, fr = lane & 15, fq = lane >> 4;
  const int nt = K / BK;
  int sR[GLA], sC[GLA];
#pragma unroll
  for (int i = 0; i < GLA; ++i) stage_rc(wid * 1024 + i * 8192 + lane * 16, sR[i], sC[i]);
#define GLDS_STAGE(buf, kt, AP, BP) do { int Kl = K; asm volatile("" : "+s"(Kl)); \
    _Pragma("unroll") for (int i = 0; i < GLA; ++i) \
      __builtin_amdgcn_global_load_lds((const u32*)((AP) + (kt) * BK + (long)i * 64 * Kl), (u32*)(SA(buf) + wid * 1024 + i * 8192), 16, 0, 0); \
    _Pragma("unroll") for (int i = 0; i < GLB; ++i) \
      __builtin_amdgcn_global_load_lds((const u32*)((BP) + (kt) * BK + (long)i * 64 * Kl), (u32*)(SB(buf) + wid * 1024 + i * 8192), 16, 0, 0); } while (0)
#define KHALF(buf, ks, mh) do { bf16x8 At[4]; \
    _Pragma("unroll") for (int m = 0; m < 4; ++m) At[m] = *(const bf16x8*)(SA(buf) + lds_byte(wr * 128 + (mh) * 64 + m * 16 + fr, (ks) * 32 + fq * 8)); \
    _Pragma("unroll") for (int m = 0; m < 4; ++m) _Pragma("unroll") for (int n = 0; n < 4; ++n) \
      acc[(mh) * 4 + m][n] = __builtin_amdgcn_mfma_f32_16x16x32_bf16(Bf[n], At[m], acc[(mh) * 4 + m][n], 0, 0, 0); } while (0)
#define KSTEP(buf, ks) do { bf16x8 Bf[4]; \
    _Pragma("unroll") for (int n = 0; n < 4; ++n) Bf[n] = *(const bf16x8*)(SB(buf) + lds_byte(wc * 64 + n * 16 + fr, (ks) * 32 + fq * 8)); \
    KHALF(buf, ks, 0); KHALF(buf, ks, 1); } while (0)
#define COMPUTE(buf) do { KSTEP(buf, 0); KSTEP(buf, 1); } while (0)

  const int sRb = (sR[0] & ~31) + 8 * ((sR[0] & 15) >> 2) + (sR[0] & 3) + ((sR[0] & 16) ? 4 : 0);
#define TILE_COORDS(wg_, brow_, bcol_) do { int wgid = (wg_); \
    { int q = nwg / NXCD, r = nwg % NXCD, xcd = wgid % NXCD, off = wgid / NXCD; \
      wgid = (xcd < r ? xcd * (q + 1) : r * (q + 1) + (xcd - r) * q) + off; } \
    int nig = WGM * nN, gid = wgid / nig, fm = gid * WGM, gsz = min(nM - fm, WGM); \
    int pm = fm + ((wgid % nig) % gsz), pn = (wgid % nig) / gsz; brow_ = pm * BM; bcol_ = pn * BN; } while (0)
  int wg0 = c.bid;
  bool have = wg0 < nwg;
  int brow = 0, bcol = 0;
  const u16* ap = A; const u16* bp = Bt;
  if (have) {
    TILE_COORDS(wg0, brow, bcol);
    ap = A + (long)brow * K + (long)sR[0] * K + sC[0];
    bp = Bt + (long)bcol * K + (long)sRb * K + sC[0];
    GLDS_STAGE(0, 0, ap, bp);
  }
  while (have) {
    f32x4 acc[8][4];
#pragma unroll
    for (int m = 0; m < 8; ++m)
#pragma unroll
      for (int n = 0; n < 4; ++n) acc[m][n] = f32x4{0.f, 0.f, 0.f, 0.f};
    const int wgn = wg0 + c.nb;
    const bool hn = wgn < nwg;
    int brn = 0, bcn = 0;
    const u16* apn = A; const u16* bpn = Bt;
    if (hn) {
      TILE_COORDS(wgn, brn, bcn);
      apn = A + (long)brn * K + (long)sR[0] * K + sC[0];
      bpn = Bt + (long)bcn * K + (long)sRb * K + sC[0];
    }
    WAIT_V(0); __syncthreads();
#pragma unroll 2
    for (int t = 0; t < nt; ++t) {
      int cur = t & 1;
      if (t + 1 < nt) GLDS_STAGE(cur ^ 1, t + 1, ap, bp);
      else if (hn) GLDS_STAGE(0, 0, apn, bpn);
      COMPUTE(cur);
      if (t + 1 < nt) { WAIT_V(0); __syncthreads(); }
    }
#define EPILOOP(EPI) \
    _Pragma("unroll") for (int m = 0; m < 8; ++m) \
    _Pragma("unroll") for (int n = 0; n < 4; n += 2) \
      EPI(brow + wr * 128 + m * 16 + fr, bcol + wc * 64 + n * 16 + fq * 8, acc[m][n], acc[m][n + 1]);
    if (gd.kind == 0) { EPILOOP(gd.eproj) }
    else if (gd.kind == 1) { EPILOOP(gd.elora) }
    else if (gd.kind == 2) { EPILOOP(gd.eresh) }
    else if (gd.kind == 4) { EPILOOP(gd.eresb) }
    else { EPILOOP(gd.erelu) }
#undef EPILOOP
    wg0 = wgn; have = hn; brow = brn; bcol = bcn; ap = apn; bp = bpn;
  }
#undef TILE_COORDS
#undef SA
#undef SB
#undef GLDS_STAGE
#undef KHALF
#undef KSTEP
#undef COMPUTE
}

__device__ void transpose_convert(const Ctx c, const float* __restrict__ src, u16* __restrict__ dst, int K, int N, int Npad, float* lds) {
  const int tid = c.tid;
  const int tk = K / 64, tn = Npad / 64, ntile = tk * tn;
  for (int t = c.bid; t < ntile; t += c.nb) {
    int k0 = (t % tk) * 64, n0 = (t / tk) * 64;
    __syncthreads();
#pragma unroll
    for (int i = 0; i < 8; ++i) {
      int kk = i * 8 + (tid >> 6), nn = tid & 63;
      float v = (n0 + nn < N) ? __builtin_nontemporal_load(src + (size_t)(k0 + kk) * N + n0 + nn) : 0.f;
      lds[kk * 65 + nn] = v;
    }
    __syncthreads();
#pragma unroll
    for (int i = 0; i < 8; ++i) {
      int nn = i * 8 + (tid >> 6), kk = tid & 63;
      dst[(size_t)(n0 + nn) * K + k0 + kk] = f2bf(lds[kk * 65 + nn]);
    }
  }
}

__device__ void convert_weights(const Ctx c, const PV& p, int l, char* shm) {
  float* lds = (float*)shm;
  transpose_convert(c, p.in(IWIN) + (size_t)l * 1024 * 3344, (u16*)(p.ws() + OFF_WIN), 1024, 3344, NPROJ, lds);
  transpose_convert(c, p.in(IWOUT) + (size_t)l * 1024 * 1024, (u16*)(p.ws() + OFF_WOUT), 1024, 1024, 1024, lds);
  transpose_convert(c, p.in(IWFC) + (size_t)l * 1024 * 4096, (u16*)(p.ws() + OFF_WFC), 1024, 4096, 4096, lds);
  transpose_convert(c, p.in(IWPROJ) + (size_t)l * 4096 * 1024, (u16*)(p.ws() + OFF_WPROJ), 4096, 1024, 1024, lds);
  u16* wl = (u16*)(p.ws() + OFF_WLORA);
  const float* wup = p.in(IWUP) + (size_t)l * 2 * 64 * 512;
  const float* aup = p.in(IAUP) + (size_t)l * 2 * 64 * 512;
  const float* gup = p.in(IGUP) + (size_t)l * 128 * 512;
  for (int idx = c.bid * 512 + c.tid; idx < 2560 * 256; idx += c.nb * 512) {
    int n = idx >> 8, k = idx & 255;
    float v = 0.f;
    if (n < 1024) { if (k < 64) { int d = n >> 9, c = n & 511; v = wup[((size_t)d * 64 + k) * 512 + c]; } }
    else if (n < 2048) { if (k >= 64 && k < 128) { int d = (n - 1024) >> 9, c = n & 511; v = aup[((size_t)d * 64 + (k - 64)) * 512 + c]; } }
    else { if (k >= 128) { int c = n - 2048; v = gup[(size_t)(k - 128) * 512 + c]; } }
    wl[idx] = f2bf(v);
  }
}

__device__ void ln_phase(const Ctx c, const float* __restrict__ src, const float* __restrict__ g, const float* __restrict__ b,
                         float* __restrict__ dstf, u16* __restrict__ dstb) {
  const int wave = c.tid >> 6, lane = c.tid & 63;
  float4 gg[4], bb[4];
#pragma unroll
  for (int i = 0; i < 4; ++i) { gg[i] = ((const float4*)g)[lane + 64 * i]; bb[i] = ((const float4*)b)[lane + 64 * i]; }
  int row = c.bid * 8 + wave;
  float4 v[4], nv[4];
  if (row < MTOK) {
#pragma unroll
    for (int i = 0; i < 4; ++i) v[i] = ldnt16f((const float4*)(src + (size_t)row * DM) + lane + 64 * i);
  }
  for (; row < MTOK; row += c.nb * 8) {
    const int nrow = row + c.nb * 8;
    if (nrow < MTOK) {
#pragma unroll
      for (int i = 0; i < 4; ++i) nv[i] = ldnt16f((const float4*)(src + (size_t)nrow * DM) + lane + 64 * i);
    }
    float sum = 0.f;
#pragma unroll
    for (int i = 0; i < 4; ++i) sum += v[i].x + v[i].y + v[i].z + v[i].w;
    float mean = wave_sum(sum) * (1.f / DM);
    float sq = 0.f;
#pragma unroll
    for (int i = 0; i < 4; ++i) {
      float a = v[i].x - mean, b2 = v[i].y - mean, c2 = v[i].z - mean, d = v[i].w - mean;
      sq += a * a + b2 * b2 + c2 * c2 + d * d;
    }
    float rstd = rsqrtf(wave_sum(sq) * (1.f / DM) + LN_EPS);
#pragma unroll
    for (int i = 0; i < 4; ++i) {
      float4 o;
      o.x = (v[i].x - mean) * rstd * gg[i].x + bb[i].x; o.y = (v[i].y - mean) * rstd * gg[i].y + bb[i].y;
      o.z = (v[i].z - mean) * rstd * gg[i].z + bb[i].z; o.w = (v[i].w - mean) * rstd * gg[i].w + bb[i].w;
      uint2 pk; pk.x = pack2(o.x, o.y); pk.y = pack2(o.z, o.w);
      ((uint2*)((u16*)dstf + (size_t)row * DM))[lane + 64 * i] = pk;
      ((uint2*)(dstb + (size_t)row * DM))[lane + 64 * i] = pk;
    }
#pragma unroll
    for (int i = 0; i < 4; ++i) v[i] = nv[i];
  }
}

__device__ __forceinline__ void unpack8(const uint4& v, float (&f)[8]) {
  f[0] = bflo(v.x); f[1] = bfhi(v.x); f[2] = bflo(v.y); f[3] = bfhi(v.y);
  f[4] = bflo(v.z); f[5] = bfhi(v.z); f[6] = bflo(v.w); f[7] = bfhi(v.w);
}
__device__ __forceinline__ uint4 pack8(const float (&f)[8]) {
  uint4 o; o.x = pack2(f[0], f[1]); o.y = pack2(f[2], f[3]); o.z = pack2(f[4], f[5]); o.w = pack2(f[6], f[7]);
  return o;
}

__device__ void ln_phase_b(const Ctx c, const u16* __restrict__ src, const float* __restrict__ g, const float* __restrict__ b,
                           float* __restrict__ dstf, u16* __restrict__ dstb, bool write_f, bool write_b, bool write_h) {
  const int wave = c.tid >> 6, lane = c.tid & 63;
  float gg[16], bb[16];
#pragma unroll
  for (int i = 0; i < 2; ++i)
#pragma unroll
    for (int e = 0; e < 8; ++e) { gg[8 * i + e] = g[8 * (lane + 64 * i) + e]; bb[8 * i + e] = b[8 * (lane + 64 * i) + e]; }
  int row = c.bid * 8 + wave;
  uint4 v[2], nv[2];
  if (row < MTOK) { v[0] = ldnt16((const uint4*)(src + (size_t)row * DM) + lane); v[1] = ldnt16((const uint4*)(src + (size_t)row * DM) + lane + 64); }
  for (; row < MTOK; row += c.nb * 8) {
    const int nrow = row + c.nb * 8;
    if (nrow < MTOK) { nv[0] = ldnt16((const uint4*)(src + (size_t)nrow * DM) + lane); nv[1] = ldnt16((const uint4*)(src + (size_t)nrow * DM) + lane + 64); }
    float x[16];
    { float t0[8], t1[8]; unpack8(v[0], t0); unpack8(v[1], t1);
#pragma unroll
      for (int e = 0; e < 8; ++e) { x[e] = t0[e]; x[8 + e] = t1[e]; } }
    float sum = 0.f;
#pragma unroll
    for (int e = 0; e < 16; ++e) sum += x[e];
    const float mean = wave_sum(sum) * (1.f / DM);
    float sq = 0.f;
#pragma unroll
    for (int e = 0; e < 16; ++e) { float dlt = x[e] - mean; sq += dlt * dlt; }
    const float rstd = rsqrtf(wave_sum(sq) * (1.f / DM) + LN_EPS);
#pragma unroll
    for (int i = 0; i < 2; ++i) {
      float o[8];
#pragma unroll
      for (int e = 0; e < 8; ++e) o[e] = (x[8 * i + e] - mean) * rstd * gg[8 * i + e] + bb[8 * i + e];
      if (write_f) {
        float4* d = (float4*)(dstf + (size_t)row * DM + 8 * (lane + 64 * i));
        __builtin_nontemporal_store(f32x4{o[0], o[1], o[2], o[3]}, (f32x4*)d);
        __builtin_nontemporal_store(f32x4{o[4], o[5], o[6], o[7]}, (f32x4*)d + 1);
      }
      if (write_b) ((uint4*)(dstb + (size_t)row * DM))[lane + 64 * i] = pack8(o);
      if (write_h) ((uint4*)((u16*)dstf + (size_t)row * DM))[lane + 64 * i] = pack8(o);
    }
    v[0] = nv[0]; v[1] = nv[1];
  }
}

constexpr int PT = 32, PB = 4;
__device__ __forceinline__ void prep_conv(const PV& p, int l, int tile, int cg) {
  const u16* proj = (const u16*)(p.ws() + OFF_P);
  const uint4 zero4 = make_uint4(0u, 0u, 0u, 0u);
  const int t0 = tile * PT, ts0 = t0 & (SEQ - 1);
  {
      const int c0 = cg * 8;
      const float* cw = p.in(ICONVW) + (size_t)l * 5 * 1024 + c0;
      const float* cb = p.in(ICONVB) + (size_t)l * 1024 + c0;
      float w[5][8], bias[8];
#pragma unroll
      for (int j = 0; j < 5; ++j)
#pragma unroll
        for (int e = 0; e < 8; ++e) w[j][e] = cw[j * 1024 + e];
#pragma unroll
      for (int e = 0; e < 8; ++e) bias[e] = cb[e];
      u16* dst; int dstride;
      if (c0 < 512) { dst = (u16*)(p.ws() + OFF_XS) + c0; dstride = 512; }
      else if (c0 < 768) { dst = (u16*)(p.ws() + OFF_BM) + (c0 - 512); dstride = 256; }
      else { dst = (u16*)(p.ws() + OFF_CM) + (c0 - 768); dstride = 256; }
      const u16* src = proj + (size_t)t0 * NPROJ + 512 + c0;
      uint4 x0, x1, x2, x3;
      x0 = (ts0 >= 2) ? ldnt16(src - 2 * (long)NPROJ) : zero4;
      x1 = (ts0 >= 1) ? ldnt16(src - (long)NPROJ) : zero4;
      x2 = ldnt16(src);
      x3 = ldnt16(src + NPROJ);
      uint4 cur[PB], nxt[PB];
#pragma unroll
      for (int u = 0; u < PB; ++u) cur[u] = (ts0 + u + 2 < SEQ) ? ldnt16(src + (long)(u + 2) * NPROJ) : zero4;
      for (int tb = 0; tb < PT; tb += PB) {
        if (tb + PB < PT) {
#pragma unroll
          for (int u = 0; u < PB; ++u) nxt[u] = (ts0 + tb + PB + u + 2 < SEQ) ? ldnt16(src + (long)(tb + PB + u + 2) * NPROJ) : zero4;
        }
#pragma unroll
        for (int u = 0; u < PB; ++u) {
          const uint4 x4 = cur[u];
          float f0[8], f1[8], f2[8], f3[8], f4[8], o[8];
          unpack8(x0, f0); unpack8(x1, f1); unpack8(x2, f2); unpack8(x3, f3); unpack8(x4, f4);
#pragma unroll
          for (int e = 0; e < 8; ++e) {
            float a = bias[e] + w[0][e] * f0[e] + w[1][e] * f1[e] + w[2][e] * f2[e] + w[3][e] * f3[e] + w[4][e] * f4[e];
            o[e] = siluf_(a);
          }
          *(uint4*)(dst + (size_t)(t0 + tb + u) * dstride) = pack8(o);
          x0 = x1; x1 = x2; x2 = x3; x3 = x4;
        }
#pragma unroll
        for (int u = 0; u < PB; ++u) cur[u] = nxt[u];
      }
  }
}

__device__ __forceinline__ void prep_rw(const PV& p, int l, int tile, int rg) {
  const u16* proj = (const u16*)(p.ws() + OFF_P);
  const uint4 zero4 = make_uint4(0u, 0u, 0u, 0u);
  const int t0 = tile * PT, ts0 = t0 & (SEQ - 1);
  {
      const int c0 = rg * 8;
      const float* mup = p.in(IMU) + (size_t)l * 1792 + c0;
      float mu[8], kkc[8];
#pragma unroll
      for (int e = 0; e < 8; ++e) mu[e] = mup[e];
      const bool isk = (rg >= 64 && rg < 128);
      if (isk) {
#pragma unroll
        for (int e = 0; e < 8; ++e) kkc[e] = p.in(IKK)[(size_t)l * 512 + (c0 - 512) + e];
      } else {
#pragma unroll
        for (int e = 0; e < 8; ++e) kkc[e] = 0.f;
      }
      u16* dst; int dstride;
      if (rg < 64) { dst = (u16*)(p.ws() + OFF_R) + c0; dstride = 512; }
      else if (rg < 128) { dst = (u16*)(p.ws() + OFF_K) + (c0 - 512); dstride = 512; }
      else if (rg < 192) { dst = (u16*)(p.ws() + OFF_V) + (c0 - 1024); dstride = 512; }
      else { dst = (u16*)(p.ws() + OFF_S) + (c0 - 1536); dstride = 256; }
      float* invn = (float*)(p.ws() + OFF_INVN);
      const u16* src = proj + (size_t)t0 * NPROJ + SSD_COLS + c0;
      uint4 xm, x0;
      xm = (ts0 >= 1) ? ldnt16(src - (long)NPROJ) : zero4;
      x0 = ldnt16(src);
      uint4 cur[PB], nxt[PB];
#pragma unroll
      for (int u = 0; u < PB; ++u) cur[u] = (ts0 + u + 1 < SEQ) ? ldnt16(src + (long)(u + 1) * NPROJ) : zero4;
      for (int tb = 0; tb < PT; tb += PB) {
        if (tb + PB < PT) {
#pragma unroll
          for (int u = 0; u < PB; ++u) nxt[u] = (ts0 + tb + PB + u + 1 < SEQ) ? ldnt16(src + (long)(tb + PB + u + 1) * NPROJ) : zero4;
        }
#pragma unroll
        for (int u = 0; u < PB; ++u) {
          const uint4 xp = cur[u];
          const int t = tb + u;
          float fm[8], f0[8], fp[8], o[8];
          unpack8(xm, fm); unpack8(x0, f0); unpack8(xp, fp);
#pragma unroll
          for (int e = 0; e < 8; ++e) o[e] = f0[e] + (0.5f * (fm[e] + fp[e]) - f0[e]) * mu[e];
          if (rg >= 192) {
            if (rg < 200) {
#pragma unroll
              for (int e = 0; e < 8; ++e) o[e] = tanhf_(o[e]);
            } else if (rg >= 208) {
#pragma unroll
              for (int e = 0; e < 8; ++e) o[e] = sigmoidf_(o[e]);
            }
          }
          const uint4 ov = pack8(o);
          *(uint4*)(dst + (size_t)(t0 + t) * dstride) = ov;
          if (isk) {
            float kr[8]; unpack8(ov, kr);
            float ss = 0.f;
#pragma unroll
            for (int e = 0; e < 8; ++e) { float qv = kr[e] * kkc[e]; ss += qv * qv; }
            ss += __shfl_xor(ss, 1); ss += __shfl_xor(ss, 2); ss += __shfl_xor(ss, 4);
            if ((rg & 7) == 0) invn[(size_t)(t0 + t) * 8 + ((rg - 64) >> 3)] = 1.f / fmaxf(sqrtf(ss), 1e-12f);
          }
          xm = x0; x0 = xp;
        }
#pragma unroll
        for (int u = 0; u < PB; ++u) cur[u] = nxt[u];
      }
  }
}

__device__ __forceinline__ void prep_z(const PV& p, int l, int tile, int zg) {
  const u16* proj = (const u16*)(p.ws() + OFF_P);
  const uint4 zero4 = make_uint4(0u, 0u, 0u, 0u);
  const int t0 = tile * PT, ts0 = t0 & (SEQ - 1);
  {
      const int c0 = zg * 8;
      const u16* src = proj + (size_t)t0 * NPROJ + c0;
      u16* dst = (u16*)(p.ws() + OFF_SZ) + c0;
      for (int tb = 0; tb < PT; tb += PB) {
        uint4 xx[PB];
#pragma unroll
        for (int u = 0; u < PB; ++u) xx[u] = ldnt16(src + (long)(tb + u) * NPROJ);
#pragma unroll
        for (int u = 0; u < PB; ++u) {
          float f[8], o[8]; unpack8(xx[u], f);
#pragma unroll
          for (int e = 0; e < 8; ++e) o[e] = siluf_(f[e]);
          *(uint4*)(dst + (size_t)(t0 + tb + u) * 512) = pack8(o);
        }
      }
  }
}

__device__ void prep_phase(const Ctx c, const PV& p, int l) {
  const int tid = c.tid;
  constexpr int NT = MTOK / PT;
  for (int g = c.bid; g < NT / 4; g += c.nb) prep_conv(p, l, g * 4 + (tid >> 7), tid & 127);
  for (int g = c.bid; g < NT / 2; g += c.nb) { const int rg = tid & 255; if (rg < 224) prep_rw(p, l, g * 2 + (tid >> 8), rg); }
  for (int g = c.bid; g < NT / 8; g += c.nb) prep_z(p, l, g * 8 + (tid >> 6), tid & 63);
  {
    const float* dtraw = (const float*)(p.ws() + OFF_DTRAW);
    float* dt = (float*)(p.ws() + OFF_DT);
    float xv[4];
#pragma unroll
    for (int u = 0; u < 4; ++u) xv[u] = dtraw[(size_t)(u * c.nb + c.bid) * 512 + tid];
    const float bia = p.in(IDTB)[(size_t)l * 16 + (tid & 15)];
#pragma unroll
    for (int u = 0; u < 4; ++u) dt[(size_t)(u * c.nb + c.bid) * 512 + tid] = softplusf_(xv[u] + bia);
  }
}

__device__ __forceinline__ float rowsum4(float x) {
  auto r = __builtin_amdgcn_permlane16_swap(__float_as_uint(x), __float_as_uint(x), false, false);
  float y = __uint_as_float(r[0]) + __uint_as_float(r[1]);
  auto r2 = __builtin_amdgcn_permlane32_swap(__float_as_uint(y), __float_as_uint(y), false, false);
  return __uint_as_float(r2[0]) + __uint_as_float(r2[1]);
}

#define DPPB(I) " row_newbcast:" #I " row_mask:0xf bank_mask:0xf\n"

__device__ __forceinline__ float dot16(const float (&S)[16], float vec) {
  float acc;
  asm volatile("s_nop 1\n"
      "v_mul_f32_dpp %0, %17, %1" DPPB(0)
      "v_fmac_f32_dpp %0, %17, %2" DPPB(1)
      "v_fmac_f32_dpp %0, %17, %3" DPPB(2)
      "v_fmac_f32_dpp %0, %17, %4" DPPB(3)
      "v_fmac_f32_dpp %0, %17, %5" DPPB(4)
      "v_fmac_f32_dpp %0, %17, %6" DPPB(5)
      "v_fmac_f32_dpp %0, %17, %7" DPPB(6)
      "v_fmac_f32_dpp %0, %17, %8" DPPB(7)
      "v_fmac_f32_dpp %0, %17, %9" DPPB(8)
      "v_fmac_f32_dpp %0, %17, %10" DPPB(9)
      "v_fmac_f32_dpp %0, %17, %11" DPPB(10)
      "v_fmac_f32_dpp %0, %17, %12" DPPB(11)
      "v_fmac_f32_dpp %0, %17, %13" DPPB(12)
      "v_fmac_f32_dpp %0, %17, %14" DPPB(13)
      "v_fmac_f32_dpp %0, %17, %15" DPPB(14)
      "v_fmac_f32_dpp %0, %17, %16" DPPB(15)
      : "=&v"(acc)
      : "v"(S[0]), "v"(S[1]), "v"(S[2]), "v"(S[3]), "v"(S[4]), "v"(S[5]), "v"(S[6]), "v"(S[7]),
        "v"(S[8]), "v"(S[9]), "v"(S[10]), "v"(S[11]), "v"(S[12]), "v"(S[13]), "v"(S[14]), "v"(S[15]), "v"(vec));
  return acc;
}

#define UPD(I, SI) \
      "v_mul_f32_dpp " SI ", %16, " SI DPPB(I) \
      "v_fmac_f32_dpp " SI ", %17, %19" DPPB(I) \
      "v_fmac_f32_dpp " SI ", %18, %20" DPPB(I)
__device__ __forceinline__ void update16(float (&S)[16], float w, float b, float kd, float nskk, float vv) {
  asm volatile("s_nop 1\n"
      UPD(0, "%0") UPD(1, "%1") UPD(2, "%2") UPD(3, "%3") UPD(4, "%4") UPD(5, "%5") UPD(6, "%6") UPD(7, "%7")
      UPD(8, "%8") UPD(9, "%9") UPD(10, "%10") UPD(11, "%11") UPD(12, "%12") UPD(13, "%13") UPD(14, "%14") UPD(15, "%15")
      : "+v"(S[0]), "+v"(S[1]), "+v"(S[2]), "+v"(S[3]), "+v"(S[4]), "+v"(S[5]), "+v"(S[6]), "+v"(S[7]),
        "+v"(S[8]), "+v"(S[9]), "+v"(S[10]), "+v"(S[11]), "+v"(S[12]), "+v"(S[13]), "+v"(S[14]), "+v"(S[15])
      : "v"(w), "v"(b), "v"(kd), "v"(nskk), "v"(vv));
}

typedef float f32x2 __attribute__((ext_vector_type(2)));
constexpr int RB = 16;
constexpr int RW_STEP = 1536;
constexpr int RW_OFF = 90112;
constexpr int RW_CNT = RW_OFF + 2 * RB * RW_STEP;
constexpr int RW_YBUF = 139520;
constexpr int XB_LDS_OFF = 147456;

__device__ __forceinline__ void group_barrier(int* cnt, int& gen, int lane);

__device__ void rwkv_scan(const PV& p, int l, int item, int tid  , char* shm, int& gen) {
  const int d = item >> 7, b = (item >> 3) & 15, h = item & 7;
  const int j = tid >> 6, lane = tid & 63, vl = lane & 15, q = lane >> 4;
  const u16* rr = (const u16*)(p.ws() + OFF_R); const u16* kk_ = (const u16*)(p.ws() + OFF_K); const u16* vv_ = (const u16*)(p.ws() + OFF_V);
  const u16* ee = (const u16*)(p.ws() + OFF_E) + (size_t)d * MTOK * 512;
  const u16* aa = (const u16*)(p.ws() + OFF_A) + (size_t)d * MTOK * 512;
  const float* invn = (const float*)(p.ws() + OFF_INVN);
  u16* yr = (u16*)(p.ws() + OFF_YR) + (size_t)d * MTOK * 512;
  int* cnt = (int*)(shm + RW_CNT);
  const int ch = h * 64 + lane, chv = h * 64 + 16 * j + vl;
  const float kkc = p.in(IKK)[(size_t)l * 512 + ch];
  const float ka = p.in(IKA)[(size_t)l * 512 + ch];
  const long tok0 = (long)b * SEQ + (d ? SEQ - 1 : 0);
  const long dstep = d ? -1 : 1;

  u16 gr[4], gk[4], ge[4], ga[4], gv[4]; float gi[4];
#define RW_LOAD(n) do { _Pragma("unroll") for (int s = 0; s < 4; ++s) { \
      long tok = tok0 + dstep * ((n) * RB + 4 * j + s); \
      gr[s] = rr[tok * 512 + ch]; gk[s] = kk_[tok * 512 + ch]; ge[s] = __builtin_nontemporal_load(ee + tok * 512 + ch); ga[s] = __builtin_nontemporal_load(aa + tok * 512 + ch); \
      gv[s] = vv_[tok * 512 + ch]; gi[s] = invn[tok * 8 + h]; } } while (0)
#define RW_WRITE(n) do { _Pragma("unroll") for (int s = 0; s < 4; ++s) { \
      float* dst = (float*)(shm + RW_OFF + ((n) & 1) * RB * RW_STEP + (4 * j + s) * RW_STEP); \
      float r = bf2f(gr[s]), k = bf2f(gk[s]), e = bf2f(ge[s]), a = bf2f(ga[s]); \
      float kkv = k * kkc * gi[s]; \
      dst[lane] = kkv; dst[64 + lane] = __expf(-e); dst[128 + lane] = kkv * a; \
      dst[192 + lane] = k * (1.f + (a - 1.f) * ka); dst[256 + lane] = r; dst[320 + lane] = bf2f(gv[s]); } } while (0)

  const int q8 = lane >> 3, rp = lane & 7;
  float S0[8], S1[8];
#pragma unroll
  for (int i = 0; i < 8; ++i) { S0[i] = 0.f; S1[i] = 0.f; }
#define FMAC(acc, a, b) acc = __builtin_fmaf(a, b, acc)
#define FMUL(dst, a, b) dst = (a) * (b)
#define REDUCE2(x0, x1, t0, t1) do { \
    float _a = x0 + __builtin_bit_cast(float, __builtin_amdgcn_update_dpp(0, __builtin_bit_cast(int, x0), 0x128, 0xf, 0xf, false)); \
    float _b = x1 + __builtin_bit_cast(float, __builtin_amdgcn_update_dpp(0, __builtin_bit_cast(int, x1), 0x128, 0xf, 0xf, false)); \
    auto _r = __builtin_amdgcn_permlane16_swap(__float_as_uint(_a), __float_as_uint(_b), false, false); \
    float _c = __uint_as_float(_r[0]) + __uint_as_float(_r[1]); \
    auto _r2 = __builtin_amdgcn_permlane32_swap(__float_as_uint(_c), __float_as_uint(_c), false, false); \
    float _d = __uint_as_float(_r2[0]) + __uint_as_float(_r2[1]); \
    auto _r3 = __builtin_amdgcn_permlane16_swap(__float_as_uint(_d), __float_as_uint(_d), false, false); \
    t0 = __uint_as_float(_r3[0]); t1 = __uint_as_float(_r3[1]); } while (0)
  u32* ybuf = (u32*)(shm + RW_YBUF) + j * (RB * 8);
  RW_LOAD(0); RW_WRITE(0);
  group_barrier(cnt, gen, lane);
  for (int n = 0; n < SEQ / RB; ++n) {
    if (n + 1 < SEQ / RB) RW_LOAD(n + 1);
    int boff = RW_OFF + (n & 1) * RB * RW_STEP + q8 * 32;
    asm volatile("" : "+v"(boff));
    const char* bufb = shm + boff;
    const int voff = 1280 - q8 * 32 + (16 * j + 2 * rp) * 4;
    f32x4 k4[2]; f32x2 vv;
    k4[0] = ((const f32x4*)bufb)[0]; k4[1] = ((const f32x4*)bufb)[1];
    vv = *(const f32x2*)(bufb + voff);
#pragma unroll
    for (int s = 0; s < RB; ++s) {
      const f32x4* P = (const f32x4*)(bufb + s * RW_STEP);
      f32x4 w4[2], b4[2], d4[2], r4[2];
#pragma unroll
      for (int i = 0; i < 2; ++i) { w4[i] = P[16 + i]; b4[i] = P[32 + i]; d4[i] = P[48 + i]; r4[i] = P[64 + i]; }
      float a0, a1;
      FMUL(a0, S0[0], k4[0][0]); FMUL(a1, S1[0], k4[0][0]);
#pragma unroll
      for (int i = 1; i < 8; ++i) { FMAC(a0, S0[i], k4[i >> 2][i & 3]); FMAC(a1, S1[i], k4[i >> 2][i & 3]); }
      float t0, t1;
      REDUCE2(a0, a1, t0, t1);
      const float ns0 = -t0, ns1 = -t1;
      const float v0 = vv[0], v1 = vv[1];
      if (s + 1 < RB) {
        k4[0] = ((const f32x4*)(bufb + (s + 1) * RW_STEP))[0]; k4[1] = ((const f32x4*)(bufb + (s + 1) * RW_STEP))[1];
        vv = *(const f32x2*)(bufb + (s + 1) * RW_STEP + voff);
      }
#pragma unroll
      for (int i = 0; i < 8; ++i) {
        FMUL(S0[i], S0[i], w4[i >> 2][i & 3]); FMUL(S1[i], S1[i], w4[i >> 2][i & 3]);
        FMAC(S0[i], ns0, b4[i >> 2][i & 3]);   FMAC(S1[i], ns1, b4[i >> 2][i & 3]);
        FMAC(S0[i], v0, d4[i >> 2][i & 3]);    FMAC(S1[i], v1, d4[i >> 2][i & 3]);
      }
      float y0, y1;
      FMUL(y0, S0[0], r4[0][0]); FMUL(y1, S1[0], r4[0][0]);
#pragma unroll
      for (int i = 1; i < 8; ++i) { FMAC(y0, S0[i], r4[i >> 2][i & 3]); FMAC(y1, S1[i], r4[i >> 2][i & 3]); }
      float yt0, yt1;
      REDUCE2(y0, y1, yt0, yt1);
      ybuf[s * 8 + rp] = pack2(yt0, yt1);
    }
    asm volatile("s_waitcnt lgkmcnt(0)" ::: "memory");
#pragma unroll
    for (int u = 0; u < 2; ++u) {
      const int s = (lane >> 3) + 8 * u;
      *(u32*)(yr + (tok0 + dstep * (n * RB + s)) * 512 + h * 64 + 16 * j + 2 * rp) = ybuf[s * 8 + rp];
    }
    if (n + 1 < SEQ / RB) RW_WRITE(n + 1);
    group_barrier(cnt, gen, lane);
  }
#undef REDUCE2
#undef FMAC
#undef FMUL
#undef RW_LOAD
#undef RW_WRITE
}

__device__ __forceinline__ void group_barrier(int* cnt, int& gen, int lane) {
  __builtin_amdgcn_fence(__ATOMIC_RELEASE, "workgroup");
  gen += 4;
  if (lane == 0) __hip_atomic_fetch_add(cnt, 1, __ATOMIC_RELAXED, __HIP_MEMORY_SCOPE_WORKGROUP);
  while (__hip_atomic_load(cnt, __ATOMIC_RELAXED, __HIP_MEMORY_SCOPE_WORKGROUP) < gen) __builtin_amdgcn_s_sleep(1);
  __builtin_amdgcn_fence(__ATOMIC_ACQUIRE, "workgroup");
}

constexpr int LC = 64;
constexpr int ST128 = 136, ST64 = 72;
constexpr int SSD_SC = 0, SSD_SB = 17408, SSD_SBT = 34816, SSD_SXT = 53248, SSD_SM = 62464, SSD_SH = 71680, SSD_CNT = 89088;

__device__ void ssd_item(const PV& p, int l, int item, int tid  , char* shm, int& gen) {
  const int d = item >> 7, b = (item >> 3) & 15, h = item & 7, g = h >> 2;
  const int w4 = tid >> 6, lane = tid & 63, wr = w4 >> 1, wc = w4 & 1, l31 = lane & 31, hi = lane >> 5;
  u16* sC = (u16*)(shm + SSD_SC); u16* sB = (u16*)(shm + SSD_SB); u16* sBT = (u16*)(shm + SSD_SBT);
  u16* sXT = (u16*)(shm + SSD_SXT); u16* sM = (u16*)(shm + SSD_SM); u16* sH = (u16*)(shm + SSD_SH);
  int* cnt = (int*)(shm + SSD_CNT);
  const u16* xs = (const u16*)(p.ws() + OFF_XS); const u16* Bm = (const u16*)(p.ws() + OFF_BM); const u16* Cm = (const u16*)(p.ws() + OFF_CM);
  const float* dt = (const float*)(p.ws() + OFF_DT);
  u16* ys = (u16*)(p.ws() + OFF_S) + (size_t)d * MTOK * 512;
  const float Aneg = -__expf(p.in(IALOG)[l * 16 + d * 8 + h]);
  for (int i = tid; i < 64 * ST128 / 2; i += 256) ((u32*)sH)[i] = 0u;
  f32x16 Hacc[2];
#pragma unroll
  for (int i = 0; i < 16; ++i) { Hacc[0][i] = 0.f; Hacc[1][i] = 0.f; }

  for (int ci = 0; ci < SEQ / LC; ++ci) {
    const int c = d ? (SEQ / LC - 1 - ci) : ci;
    const long tokbase = (long)b * SEQ + c * LC;
#define TOK(lr) (tokbase + (d ? (LC - 1 - (lr)) : (lr)))
    const float dtv = dt[TOK(lane) * 16 + d * 8 + h];
    float cs = dtv * Aneg;
#pragma unroll
    for (int o = 1; o < 64; o <<= 1) { float t = __shfl_up(cs, o); if (lane >= o) cs += t; }
    const float cs_last = __shfl(cs, 63);
#pragma unroll
    for (int i = 0; i < 4; ++i) {
      int idx = tid + 256 * i, row = idx & 63, seg = idx >> 6;
      long tk = TOK(row);
      uint4 cvv = *(const uint4*)(Cm + tk * 256 + g * 128 + seg * 8);
      uint4 bvv = *(const uint4*)(Bm + tk * 256 + g * 128 + seg * 8);
      *(uint4*)(sC + row * ST128 + seg * 8) = cvv;
      *(uint4*)(sB + row * ST128 + seg * 8) = bvv;
      float dec = __expf(cs_last - cs);
      u32 bw[4] = {bvv.x, bvv.y, bvv.z, bvv.w};
#pragma unroll
      for (int q = 0; q < 4; ++q) {
        sBT[(seg * 8 + 2 * q) * ST64 + row] = f2bf(bflo(bw[q]) * dec);
        sBT[(seg * 8 + 2 * q + 1) * ST64 + row] = f2bf(bfhi(bw[q]) * dec);
      }
    }
#pragma unroll
    for (int i = 0; i < 2; ++i) {
      int idx = tid + 256 * i, row = idx & 63, seg = idx >> 6;
      long tk = TOK(row);
      uint4 xv = *(const uint4*)(xs + tk * 512 + h * 64 + seg * 8);
      float dts = dtv;
      u32 xw[4] = {xv.x, xv.y, xv.z, xv.w};
#pragma unroll
      for (int q = 0; q < 4; ++q) {
        sXT[(seg * 8 + 2 * q) * ST64 + row] = f2bf(bflo(xw[q]) * dts);
        sXT[(seg * 8 + 2 * q + 1) * ST64 + row] = f2bf(bfhi(xw[q]) * dts);
      }
    }
    group_barrier(cnt, gen, lane);
    {
      f32x16 acc;
#pragma unroll
      for (int i = 0; i < 16; ++i) acc[i] = 0.f;
#pragma unroll
      for (int kb = 0; kb < 8; ++kb) {
        bf16x8 a = *(const bf16x8*)(sC + (32 * wr + l31) * ST128 + kb * 16 + hi * 8);
        bf16x8 bb = *(const bf16x8*)(sB + (32 * wc + l31) * ST128 + kb * 16 + hi * 8);
        acc = __builtin_amdgcn_mfma_f32_32x32x16_bf16(a, bb, acc, 0, 0, 0);
      }
      const int s = 32 * wc + l31;
      const float cs_s = __shfl(cs, s);
#pragma unroll
      for (int i = 0; i < 16; ++i) {
        int lrow = 32 * wr + 8 * (i >> 2) + 4 * hi + (i & 3);
        const int lr0 = 32 * wr + 8 * (i >> 2) + (i & 3);
        float cs_l = __uint_as_float(hi ? __builtin_amdgcn_readlane(__float_as_uint(cs), lr0 + 4) : __builtin_amdgcn_readlane(__float_as_uint(cs), lr0));
        float m = (s <= lrow) ? acc[i] * __expf(cs_l - cs_s) : 0.f;
        sM[lrow * ST64 + s] = f2bf(m);
      }
    }
    group_barrier(cnt, gen, lane);
    {
      f32x16 acc1, acc2;
#pragma unroll
      for (int i = 0; i < 16; ++i) { acc1[i] = 0.f; acc2[i] = 0.f; }
#pragma unroll
      for (int kb = 0; kb < 4; ++kb) {
        bf16x8 a = *(const bf16x8*)(sM + (32 * wr + l31) * ST64 + kb * 16 + hi * 8);
        bf16x8 bb = *(const bf16x8*)(sXT + (32 * wc + l31) * ST64 + kb * 16 + hi * 8);
        acc1 = __builtin_amdgcn_mfma_f32_32x32x16_bf16(a, bb, acc1, 0, 0, 0);
      }
#pragma unroll
      for (int kb = 0; kb < 8; ++kb) {
        bf16x8 a = *(const bf16x8*)(sC + (32 * wr + l31) * ST128 + kb * 16 + hi * 8);
        bf16x8 bb = *(const bf16x8*)(sH + (32 * wc + l31) * ST128 + kb * 16 + hi * 8);
        acc2 = __builtin_amdgcn_mfma_f32_32x32x16_bf16(a, bb, acc2, 0, 0, 0);
      }
      const int pcol = h * 64 + 32 * wc + l31;
#pragma unroll
      for (int i = 0; i < 16; ++i) {
        int lrow = 32 * wr + 8 * (i >> 2) + 4 * hi + (i & 3);
        const int lr0 = 32 * wr + 8 * (i >> 2) + (i & 3);
        const float cs_l = __uint_as_float(hi ? __builtin_amdgcn_readlane(__float_as_uint(cs), lr0 + 4) : __builtin_amdgcn_readlane(__float_as_uint(cs), lr0));
        float y = acc1[i] + __expf(cs_l) * acc2[i];
        ys[TOK(lrow) * 512 + pcol] = f2bf(y);
      }
    }
    group_barrier(cnt, gen, lane);
    {
      const float dall = __expf(cs_last);
#pragma unroll
      for (int nt = 0; nt < 2; ++nt) {
#pragma unroll
        for (int i = 0; i < 16; ++i) Hacc[nt][i] *= dall;
#pragma unroll
        for (int kb = 0; kb < 4; ++kb) {
          bf16x8 a = *(const bf16x8*)(sXT + (32 * wr + l31) * ST64 + kb * 16 + hi * 8);
          bf16x8 bb = *(const bf16x8*)(sBT + (64 * wc + 32 * nt + l31) * ST64 + kb * 16 + hi * 8);
          Hacc[nt] = __builtin_amdgcn_mfma_f32_32x32x16_bf16(a, bb, Hacc[nt], 0, 0, 0);
        }
#pragma unroll
        for (int i = 0; i < 16; ++i) {
          int prow = 32 * wr + 8 * (i >> 2) + 4 * hi + (i & 3);
          sH[prow * ST128 + 64 * wc + 32 * nt + l31] = f2bf(Hacc[nt][i]);
        }
      }
    }
    group_barrier(cnt, gen, lane);
#undef TOK
  }
}

__device__ void mixer_phase(const Ctx c, const PV& p, int l, char* shm) {
  int* cnt = (int*)(shm + SSD_CNT);
  int* cnt2 = (int*)(shm + RW_CNT);
  if (c.tid == 0) { *cnt = 0; *cnt2 = 0; }
  __syncthreads();
  int gen = 0;
  if (c.tid < 256) {
    for (int rep = 0; rep < ((PROBE_MIX & 1) ? 2 : 1); ++rep)
    for (int it = c.bid; it < 256; it += c.nb) rwkv_scan(p, l, it, c.tid, shm, gen);
  } else {
    for (int rep = 0; rep < ((PROBE_MIX & 2) ? 2 : 1); ++rep)
    for (int it = c.bid; it < 256; it += c.nb) ssd_item(p, l, it, c.tid - 256, shm, gen);
  }
}

__device__ void post_phase(const Ctx c, const PV& p, int l) {
  const int wave = c.tid >> 6, lane = c.tid & 63;
  const u16* xs = (const u16*)(p.ws() + OFF_XS); const u16* sz = (const u16*)(p.ws() + OFF_SZ);
  const u16* ys = (const u16*)(p.ws() + OFF_S);
  const u16* yr = (const u16*)(p.ws() + OFF_YR);
  const u16* rr = (const u16*)(p.ws() + OFF_R); const u16* kk_ = (const u16*)(p.ws() + OFF_K); const u16* vv = (const u16*)(p.ws() + OFF_V);
  const u16* aa = (const u16*)(p.ws() + OFF_A); const u16* gg = (const u16*)(p.ws() + OFF_G);
  u16* ymix = (u16*)(p.ws() + OFF_YMIX);
  const float* dskip = p.in(IDSKIP) + l * 8;
  const float* ng = p.in(ISSDG) + (size_t)l * 512;
  const float* ka = p.in(IKA) + (size_t)l * 512; const float* rk = p.in(IRK) + (size_t)l * 512;
  const float* lg = p.in(ILNXG) + (size_t)l * 512; const float* lb = p.in(ILNXB) + (size_t)l * 512;
  const int c0 = lane * 8;
  float ngv[8], kav[8], rkv[8], lgv[8], lbv[8];
#pragma unroll
  for (int e = 0; e < 8; ++e) { ngv[e] = ng[c0 + e]; kav[e] = ka[c0 + e]; rkv[e] = rk[c0 + e]; lgv[e] = lg[c0 + e]; lbv[e] = lb[c0 + e]; }
  const float ds = dskip[lane >> 3];
#define POST_LOAD(D, tok_) do { const size_t o_ = (size_t)(tok_) * 512 + c0; \
    D[0] = ldnt16(ys + o_); D[1] = ldnt16(ys + (size_t)MTOK * 512 + o_); \
    D[2] = ldnt16(xs + o_); D[3] = ldnt16(sz + o_); \
    D[4] = ldnt16(yr + o_); D[5] = ldnt16(yr + (size_t)MTOK * 512 + o_); \
    D[6] = ldnt16(rr + o_); D[7] = ldnt16(kk_ + o_); D[8] = ldnt16(vv + o_); D[9] = ldnt16(gg + o_); \
    D[10] = ldnt16(aa + o_); D[11] = ldnt16(aa + (size_t)MTOK * 512 + o_); } while (0)
  int tok = c.bid * 8 + wave;
  uint4 L[12], N[12];
  if (tok < MTOK) POST_LOAD(L, tok);
  for (; tok < MTOK; tok += c.nb * 8) {
    const int ntok = tok + c.nb * 8;
    if (ntok < MTOK) POST_LOAD(N, ntok);
    {
      float f[8], bk[8], x[8], z[8];
      unpack8(L[0], f); unpack8(L[1], bk); unpack8(L[2], x); unpack8(L[3], z);
      float y[8]; float ss = 0.f;
#pragma unroll
      for (int e = 0; e < 8; ++e) { y[e] = (f[e] + bk[e] + ds * x[e]) * z[e]; ss += y[e] * y[e]; }
#pragma unroll
      for (int off = 16; off >= 1; off >>= 1) ss += __shfl_xor(ss, off);
      const float rs = rsqrtf(ss * (1.f / 256.f) + RMS_EPS);
      float ov[8];
#pragma unroll
      for (int e = 0; e < 8; ++e) ov[e] = y[e] * rs * ngv[e];
      *(uint4*)(ymix + (size_t)tok * 1024 + c0) = pack8(ov);
    }
    {
      float yf[8], yb[8], r[8], k[8], vf[8], gf[8], af[8], ab[8];
      unpack8(L[4], yf); unpack8(L[5], yb); unpack8(L[6], r); unpack8(L[7], k); unpack8(L[8], vf); unpack8(L[9], gf);
      unpack8(L[10], af); unpack8(L[11], ab);
      float y[8]; float sum = 0.f, bon = 0.f;
#pragma unroll
      for (int e = 0; e < 8; ++e) {
        y[e] = yf[e] + yb[e]; sum += y[e];
        bon += r[e] * k[e] * rkv[e] * (2.f + (af[e] + ab[e] - 2.f) * kav[e]);
      }
#pragma unroll
      for (int off = 4; off >= 1; off >>= 1) { sum += __shfl_xor(sum, off); bon += __shfl_xor(bon, off); }
      const float mean = sum * (1.f / 64.f);
      float sq = 0.f;
#pragma unroll
      for (int e = 0; e < 8; ++e) { float dlt = y[e] - mean; sq += dlt * dlt; }
#pragma unroll
      for (int off = 4; off >= 1; off >>= 1) sq += __shfl_xor(sq, off);
      const float rstd = rsqrtf(sq * (1.f / 64.f) + GN_EPS);
      float ov[8];
#pragma unroll
      for (int e = 0; e < 8; ++e) ov[e] = ((y[e] - mean) * rstd * lgv[e] + lbv[e] + bon * vf[e]) * gf[e];
      *(uint4*)(ymix + (size_t)tok * 1024 + 512 + c0) = pack8(ov);
    }
#pragma unroll
    for (int i = 0; i < 12; ++i) L[i] = N[i];
  }
#undef POST_LOAD
}

#define XB_TMO      128
#define XB_XCNT(j)  (256  + 64 * (j))
#define XB_XSUB(j)  (1280 + 64 * (j))
#define XB_XGEN(j)  (2304 + 64 * (j))
#define XB_TOP      3328
#define XB_TOPGEN   3392
#define XCD_BAR_WORDS 3456
#define XB_SPIN_CAP (1u << 18)
#define LAS __attribute__((address_space(3)))

__device__ __forceinline__ unsigned xb_ld(unsigned* p)              { return __hip_atomic_load(p, __ATOMIC_RELAXED, __HIP_MEMORY_SCOPE_AGENT); }
__device__ __forceinline__ unsigned xb_add(unsigned* p, unsigned v) { return __hip_atomic_fetch_add(p, v, __ATOMIC_RELAXED, __HIP_MEMORY_SCOPE_AGENT); }
__device__ __forceinline__ unsigned xb_xcc_id() { return (unsigned)__builtin_amdgcn_s_getreg((3 << 11) | 20) & 0xFu; }
#define XB_SPIN(cond, bar) do { unsigned _sp = 0; while (cond) { __builtin_amdgcn_s_sleep(1); \
    if ((++_sp & 255u) == 0u) { if (xb_ld(&(bar)[XB_TMO])) break; if (_sp > XB_SPIN_CAP) { atomicAdd(&(bar)[XB_TMO], 1u); break; } } } } while (0)

struct XcdBarrier {
    unsigned* bar; unsigned x; unsigned wv;
    volatile LAS unsigned* st;
};

__device__ __forceinline__ XcdBarrier xcd_barrier_post(unsigned* bar, volatile LAS unsigned* st) {
    XcdBarrier b; b.bar = bar; b.x = xb_xcc_id(); b.st = st; b.wv = (unsigned)__builtin_amdgcn_readfirstlane((int)(threadIdx.x >> 6));
    if (threadIdx.x == 0) (void)xb_add(&bar[XB_XCNT(b.x)], 1u);
    return b;
}
__device__ __forceinline__ void xcd_barrier_complete(unsigned* bar, unsigned x, unsigned& nloc, unsigned& nx) {
    const unsigned G = gridDim.x * gridDim.y * gridDim.z;
    unsigned sum, cnt, mine, sp = 0u;
    for (;;) {
        sum = 0u; cnt = 0u; mine = 0u;
#pragma unroll
        for (unsigned j = 0; j < 16; ++j) { const unsigned c = xb_ld(&bar[XB_XCNT(j)]); sum += c; cnt += (c > 0u) ? 1u : 0u; mine = (j == x) ? c : mine; }
        if (sum == G) break;
        __builtin_amdgcn_s_sleep(1);
        if ((++sp & 255u) == 0u) { if (xb_ld(&bar[XB_TMO])) break; if (sp > XB_SPIN_CAP) { atomicAdd(&bar[XB_TMO], 1u); break; } }
    }
    nloc = mine > 0u ? mine : 1u; nx = cnt > 0u ? cnt : 1u;
}

__device__ __forceinline__ void xcd_barrier(const XcdBarrier& b) {
    asm volatile("s_waitcnt vmcnt(0)" ::: "memory");
    __syncthreads();
    if (b.wv == 0u && lane_id_() == 0) {
        unsigned* bar = b.bar;
        __builtin_amdgcn_s_waitcnt(0);
        unsigned nloc = b.st[0], nx = b.st[1];
        if (nloc == 0u) { xcd_barrier_complete(bar, b.x, nloc, nx); b.st[0] = nloc; b.st[1] = nx; }
        const unsigned old = xb_add(&bar[XB_XSUB(b.x)], 1u);
        const unsigned gen = old / nloc;
        if (old + 1u == (gen + 1u) * nloc) {
            __builtin_amdgcn_fence(__ATOMIC_RELEASE, "agent");
            asm volatile("s_waitcnt vmcnt(0)" ::: "memory");
            const unsigned og = xb_add(&bar[XB_TOP], 1u);
            const unsigned tg = og / nx;
            if (og + 1u == (tg + 1u) * nx) xb_add(&bar[XB_TOPGEN], 1u);
            else XB_SPIN(xb_ld(&bar[XB_TOPGEN]) == tg, bar);
            __builtin_amdgcn_fence(__ATOMIC_ACQUIRE, "agent");
            xb_add(&bar[XB_XGEN(b.x)], 1u);
            asm volatile("s_waitcnt vmcnt(0)" ::: "memory");
        } else {
            XB_SPIN(xb_ld(&bar[XB_XGEN(b.x)]) == gen, bar);
            __builtin_amdgcn_fence(__ATOMIC_ACQUIRE, "agent");
            asm volatile("s_waitcnt vmcnt(0)" ::: "memory");
        }
    }
    __syncthreads();
}


constexpr int NPHASE = 21;

__device__ __forceinline__ void run_phase(const Ctx c, const PV& p, int ph, char* shm) {
  const int l = (ph == 0) ? 0 : (ph - 1) / 10, s = (ph == 0) ? -1 : (ph - 1) % 10;
  if (s == 0 || s == 2 || s == 5 || s == 7 || s == 8) {
    GemmDesc gd{};
    gd.eproj = EpiProj{(u16*)(p.ws() + OFF_P), (float*)(p.ws() + OFF_DTRAW)};
    gd.elora = EpiLora{(u16*)(p.ws() + OFF_E), (u16*)(p.ws() + OFF_A), (u16*)(p.ws() + OFF_G), p.in(IW0) + (size_t)l * 1024, p.in(IA0) + (size_t)l * 1024};
    gd.eresh = EpiResidB{(u16*)(p.ws() + OFF_PRE), (const u16*)p.out()};
    gd.eresb = EpiResidB{(u16*)(p.ws() + OFF_PRE), (const u16*)(p.ws() + OFF_H)};
    gd.erelu = EpiRelu2{(u16*)(p.ws() + OFF_ACT)};
    if (s == 0)      { gd.A = (const u16*)(p.ws() + OFF_H);    gd.Bt = (const u16*)(p.ws() + OFF_WIN);   gd.N = NPROJ; gd.K = DM;  gd.kind = 0; }
    else if (s == 2) { gd.A = (const u16*)(p.ws() + OFF_S);    gd.Bt = (const u16*)(p.ws() + OFF_WLORA); gd.N = 2560;  gd.K = 256; gd.kind = 1; }
    else if (s == 5) { gd.A = (const u16*)(p.ws() + OFF_YMIX); gd.Bt = (const u16*)(p.ws() + OFF_WOUT);  gd.N = DM;    gd.K = DM;  gd.kind = 2; }
    else if (s == 7) { gd.A = (const u16*)(p.ws() + OFF_H);    gd.Bt = (const u16*)(p.ws() + OFF_WFC);   gd.N = DFF;   gd.K = DM;  gd.kind = 3; }
    else             { gd.A = (const u16*)(p.ws() + OFF_ACT);  gd.Bt = (const u16*)(p.ws() + OFF_WPROJ); gd.N = DM;    gd.K = DFF; gd.kind = 4; }
    gemm_phase(c, gd, shm);
    return;
  }
  switch (s) {
    case -1:
#if PROBE_CLK
      if (c.tid < 256) {
        float a = (float)c.tid, b = 1.0000001f, cc = 1e-9f;
        for (int it = 0; it < 32768; ++it) { a = rowsum4(a) * b + cc; }
        if (a == 12345.678f) p.out()[0] = a;
      }
#endif
      ln_phase(c, p.in(IX), p.in(ILN0G), p.in(ILN0B), p.out(), (u16*)(p.ws() + OFF_H));
      convert_weights(c, p, 0, shm);
      break;
    case 1: prep_phase(c, p, l); break;
    case 3: mixer_phase(c, p, l, shm); break;
    case 4: post_phase(c, p, l); break;
    case 6: ln_phase_b(c, (const u16*)(p.ws() + OFF_PRE), p.in(ILN1G) + (size_t)l * DM, p.in(ILN1B) + (size_t)l * DM, p.out(), (u16*)(p.ws() + OFF_H), false, true, false); break;
    case 9:
      ln_phase_b(c, (const u16*)(p.ws() + OFF_PRE), p.in(ILN2G) + (size_t)l * DM, p.in(ILN2B) + (size_t)l * DM, p.out(), (u16*)(p.ws() + OFF_H), l != 0, l == 0, l == 0);
      if (l == 0) convert_weights(c, p, 1, shm);
      break;
    default: break;
  }
}

__global__ void __launch_bounds__(512) mega(Params p, int lo, int hi) {
  extern __shared__ __attribute__((aligned(16))) char shm[];
  volatile LAS unsigned* xst = (volatile LAS unsigned*)(shm + XB_LDS_OFF);
  if (threadIdx.x == 0) { xst[0] = 0u; xst[1] = 0u; xst[2] = 0u; xst[3] = 0u; }
  __syncthreads();
  XcdBarrier xb = xcd_barrier_post((unsigned*)(p.ws + OFF_BAR), xst);
  if (hi > 1000) cg::this_grid().sync();
#if PROBE_SYNC
  if (hi - lo > 1) { for (int i = 0; i < 20; ++i) xcd_barrier(xb); }
#endif
  for (int ph = lo; ph < hi; ++ph) {
    int reps = 1;
#if PROBE_REP
    if (ph > 0 && ((PROBE_REP >> ((ph - 1) % 10)) & 1)) reps = 2;
#endif
    for (int rep = 0; rep < reps; ++rep) {
      long z; int zi;
      asm volatile("s_mov_b64 %0, 0\n\ts_mov_b32 %1, 0" : "=s"(z), "=s"(zi));
      const PV q{p, z};
      int tidv = (int)xb.wv * 64 + lane_id_(); asm volatile("" : "+v"(tidv));
      Ctx c{tidv, (int)blockIdx.x + zi, (int)gridDim.x + zi};
      run_phase(c, q, ph, shm);
      if (rep + 1 < reps || ph + 1 < hi) { xcd_barrier(xb); }
    }
  }
}

extern "C" void kernel_launch(void* const* d_in, const int* in_sizes, int n_in, void* d_out, int out_size,
                              void* d_ws, size_t ws_size, hipStream_t stream) {
  if (ws_size < WS_NEED) { fprintf(stderr, "workspace too small: %zu < %zu\n", ws_size, WS_NEED); return; }
  Params p{};
  for (int i = 0; i < NIN; ++i) p.in[i] = (const float*)d_in[i];
  p.out = (float*)d_out;
  p.ws = (char*)d_ws;
  hipFuncSetAttribute((const void*)mega, hipFuncAttributeMaxDynamicSharedMemorySize, SHM_BYTES);
#if COOP
  hipMemsetAsync((char*)d_ws + OFF_BAR, 0, XCD_BAR_WORDS * sizeof(unsigned), stream);
  int lo = 0, hi = NPHASE;
  void* args[] = {&p, &lo, &hi};
  hipError_t e = hipLaunchCooperativeKernel((const void*)mega, dim3(256), dim3(512), args, SHM_BYTES, stream);
  if (e != hipSuccess) fprintf(stderr, "cooperative launch failed: %s\n", hipGetErrorString(e));
#else
  for (int ph = 0; ph < NPHASE; ++ph) mega<<<dim3(256), dim3(512), SHM_BYTES, stream>>>(p, ph, ph + 1);
#endif
}
```

```cpp
#include <hip/hip_runtime.h>
#include <hip/hip_bf16.h>
#include <hip/hip_cooperative_groups.h>
#include <cstdio>
namespace cg = cooperative_groups;

#ifndef COOP
#define COOP 1
#endif
#define PROBE_MIX 0
#define PROBE_CLK 0
#define PROBE_SYNC 0
#define GEMM_REGSTAGE 0
#define PROBE_REP 0x000

typedef unsigned short u16;
typedef unsigned int u32;
using bf16x8 = __attribute__((ext_vector_type(8))) short;
using f32x4 = __attribute__((ext_vector_type(4))) float;
using f32x16 = __attribute__((ext_vector_type(16))) float;
using i32x4 = __attribute__((ext_vector_type(4))) int;

constexpr int MTOK = 32768, SEQ = 2048, DM = 1024, DFF = 4096;
constexpr int NPROJ = 3584;
constexpr int SSD_COLS = 1552;
constexpr float ALPHA = 1.4142135623730951f;
constexpr float LN_EPS = 1e-5f, RMS_EPS = 1e-5f, GN_EPS = 64e-5f;

enum { IX=0, ILN0G, ILN0B, IWIN, ICONVW, ICONVB, IDTB, IALOG, IDSKIP, ISSDG, IMU, IW0, IWUP, IA0, IAUP, IGUP,
       IKK, IKA, IRK, ILNXG, ILNXB, IWOUT, ILN1G, ILN1B, IWFC, IWPROJ, ILN2G, ILN2B, NIN };

constexpr size_t OFF_WIN = 0;
constexpr size_t OFF_WOUT = 7340032;
constexpr size_t OFF_WFC = 9437184;
constexpr size_t OFF_WPROJ = 17825792;
constexpr size_t OFF_WLORA = 26214400;
constexpr size_t OFF_H = 27525120;
constexpr size_t OFF_XS = OFF_H;
constexpr size_t OFF_BM = OFF_H + 33554432;
constexpr size_t OFF_CM = OFF_H + 50331648;
constexpr size_t OFF_P = OFF_H + 67108864;
constexpr size_t OFF_E = OFF_P;
constexpr size_t OFF_A = OFF_P + 67108864;
constexpr size_t OFF_G = OFF_P + 134217728;
constexpr size_t OFF_YR = OFF_P + 167772160;
constexpr size_t OFF_YMIX = OFF_P;
constexpr size_t OFF_ACT = OFF_P;
constexpr size_t OFF_S = OFF_P + 234881024;
constexpr size_t OFF_Q = OFF_S + 67108864;
constexpr size_t OFF_R = OFF_Q;
constexpr size_t OFF_K = OFF_Q + 33554432;
constexpr size_t OFF_V = OFF_Q + 67108864;
constexpr size_t OFF_SZ = OFF_Q + 100663296;
constexpr size_t OFF_PRE = OFF_Q;
constexpr size_t OFF_SM = OFF_Q + 134217728;
constexpr size_t OFF_DT = OFF_SM;
constexpr size_t OFF_INVN = OFF_SM + 2097152;
constexpr size_t OFF_DTRAW = OFF_S + 50331648;
constexpr size_t OFF_BAR = OFF_SM + 4194304;
constexpr size_t WS_NEED = OFF_BAR + 16384;

struct Params {
  const float* in[NIN];
  float* out;
  char* ws;
};
struct Ctx { int tid, bid, nb; };
__device__ __forceinline__ int lane_id_() { int l; asm volatile("v_mbcnt_lo_u32_b32 %0, -1, 0\n\tv_mbcnt_hi_u32_b32 %0, -1, %0" : "=v"(l)); return l; }
struct PV {
  const Params& pr; long z;
  __device__ __forceinline__ const float* in(int i) const { return pr.in[i] + z; }
  __device__ __forceinline__ char* ws() const { return pr.ws + z; }
  __device__ __forceinline__ float* out() const { return pr.out + z; }
};

typedef __bf16 hwbf16x2 __attribute__((ext_vector_type(2)));
typedef float hwf32x2 __attribute__((ext_vector_type(2)));
__device__ __forceinline__ u16 f2bf(float f) { __bf16 r = (__bf16)f; return __builtin_bit_cast(u16, r); }
__device__ __forceinline__ float bf2f(u16 h) { return __uint_as_float(((u32)h) << 16); }
__device__ __forceinline__ float bflo(u32 w) { return __uint_as_float(w << 16); }
__device__ __forceinline__ float bfhi(u32 w) { return __uint_as_float(w & 0xffff0000u); }
__device__ __forceinline__ u32 pack2(float a, float b) { hwf32x2 v{a, b}; hwbf16x2 r = __builtin_convertvector(v, hwbf16x2); return __builtin_bit_cast(u32, r); }
__device__ __forceinline__ float sigmoidf_(float x) { return __builtin_amdgcn_rcpf(1.f + __expf(-x)); }
__device__ __forceinline__ float siluf_(float x) { return x * __builtin_amdgcn_rcpf(1.f + __expf(-x)); }
__device__ __forceinline__ float tanhf_(float x) { return 1.f - 2.f * __builtin_amdgcn_rcpf(1.f + __expf(2.f * x)); }
__device__ __forceinline__ float softplusf_(float x) { return fmaxf(x, 0.f) + log1pf(__expf(-fabsf(x))); }
__device__ __forceinline__ uint4 ldnt16(const void* p) {
  i32x4 v = __builtin_nontemporal_load((const i32x4*)p);
  return make_uint4((u32)v[0], (u32)v[1], (u32)v[2], (u32)v[3]);
}
__device__ __forceinline__ float4 ldnt16f(const void* p) {
  uint4 v = ldnt16(p);
  return make_float4(__uint_as_float(v.x), __uint_as_float(v.y), __uint_as_float(v.z), __uint_as_float(v.w));
}
__device__ __forceinline__ float wave_sum(float v) {
#pragma unroll
  for (int o = 32; o >= 1; o >>= 1) v += __shfl_xor(v, o);
  return v;
}

__device__ __forceinline__ uint4 pack8v(f32x4 a, f32x4 b) {
  uint4 o; o.x = pack2(a[0], a[1]); o.y = pack2(a[2], a[3]); o.z = pack2(b[0], b[1]); o.w = pack2(b[2], b[3]);
  return o;
}
struct EpiProj {
  u16* proj; float* dt;
  __device__ __forceinline__ void operator()(int row, int col, f32x4 v, f32x4 w) const {
    *(uint4*)(proj + (size_t)row * NPROJ + col) = pack8v(v, w);
    if (col >= 1536 && col < 1552) { f32x4* d = (f32x4*)(dt + (size_t)row * 16 + (col - 1536)); d[0] = v; d[1] = w; }
  }
};
struct EpiLora {
  u16* e; u16* a; u16* g; const float* w0; const float* a0;
  __device__ __forceinline__ void operator()(int row, int col, f32x4 v, f32x4 w) const {
    if (col < 1024) {
      int d = col >> 9, c = col & 511;
      f32x4 b0 = *(const f32x4*)(w0 + col), b1 = *(const f32x4*)(w0 + col + 4);
      f32x4 o0, o1;
#pragma unroll
      for (int j = 0; j < 4; ++j) { o0[j] = 0.6065306597126334f * sigmoidf_(b0[j] + v[j]); o1[j] = 0.6065306597126334f * sigmoidf_(b1[j] + w[j]); }
      *(uint4*)(e + ((size_t)d * MTOK + row) * 512 + c) = pack8v(o0, o1);
    } else if (col < 2048) {
      int cc = col - 1024, d = cc >> 9, c = cc & 511;
      f32x4 b0 = *(const f32x4*)(a0 + cc), b1 = *(const f32x4*)(a0 + cc + 4);
      f32x4 o0, o1;
#pragma unroll
      for (int j = 0; j < 4; ++j) { o0[j] = sigmoidf_(b0[j] + v[j]); o1[j] = sigmoidf_(b1[j] + w[j]); }
      *(uint4*)(a + ((size_t)d * MTOK + row) * 512 + c) = pack8v(o0, o1);
    } else {
      *(uint4*)(g + (size_t)row * 512 + (col - 2048)) = pack8v(v, w);
    }
  }
};
struct EpiResid {
  u16* pre; const float* h;
  __device__ __forceinline__ void operator()(int row, int col, f32x4 v, f32x4 w) const {
    size_t o = (size_t)row * DM + col;
    f32x4 h0 = *(const f32x4*)(h + o), h1 = *(const f32x4*)(h + o + 4);
    *(uint4*)(pre + o) = pack8v(h0 * ALPHA + v, h1 * ALPHA + w);
  }
};
struct EpiResidB {
  u16* pre; const u16* hb;
  __device__ __forceinline__ void operator()(int row, int col, f32x4 v, f32x4 w) const {
    size_t o = (size_t)row * DM + col;
    uint4 hv = ldnt16(hb + o);
    f32x4 h0 = f32x4{bflo(hv.x), bfhi(hv.x), bflo(hv.y), bfhi(hv.y)}, h1 = f32x4{bflo(hv.z), bfhi(hv.z), bflo(hv.w), bfhi(hv.w)};
    *(uint4*)(pre + o) = pack8v(h0 * ALPHA + v, h1 * ALPHA + w);
  }
};
struct EpiRelu2 {
  u16* act;
  __device__ __forceinline__ void operator()(int row, int col, f32x4 v, f32x4 w) const {
    f32x4 r0, r1;
#pragma unroll
    for (int j = 0; j < 4; ++j) { float a = fmaxf(v[j], 0.f), b = fmaxf(w[j], 0.f); r0[j] = a * a; r1[j] = b * b; }
    *(uint4*)(act + (size_t)row * DFF + col) = pack8v(r0, r1);
  }
};

constexpr int BM = 256, BN = 256, BK = 64, NXCD = 8, WGM = 8;
constexpr int SHM_BYTES = 147520;

__device__ __forceinline__ int lds_byte(int r, int c) {
  int st = (r >> 4) * 2 + (c >> 5), rr = r & 15, cc = c & 31, ob = rr * 64 + cc * 2;
  return st * 1024 + (ob ^ (((ob >> 9) & 1) << 5));
}
__device__ __forceinline__ void stage_rc(int b, int& R, int& C) {
  int st = b / 1024, sb = b % 1024, swz = sb ^ (((sb >> 9) & 1) << 5);
  R = (st >> 1) * 16 + swz / 64; C = (st & 1) * 32 + (swz % 64) / 2;
}

struct GemmDesc {
  const u16* A; const u16* Bt; int N, K, kind;
  EpiProj eproj; EpiLora elora; EpiResidB eresh; EpiResidB eresb; EpiRelu2 erelu;
};

__device__ __forceinline__ void gemm_phase(const Ctx c, const GemmDesc& gd, char* shm) {
  const u16* __restrict__ A = gd.A; const u16* __restrict__ Bt = gd.Bt;
  const int M = MTOK, N = gd.N, K = gd.K;
  constexpr int TILE_A = BM * BK * 2, TILE_B = BN * BK * 2, GLA = TILE_A / 8192, GLB = TILE_B / 8192, STAGE_B = TILE_A + TILE_B;
#define SA(b) (shm + (b) * STAGE_B)
#define SB(b) (shm + (b) * STAGE_B + TILE_A)
#define WAIT_V(n) asm volatile("s_waitcnt vmcnt(%0)" ::"n"(n) : "memory")
#define SCHED() __builtin_amdgcn_sched_barrier(0)
#define RAW_BARRIER() do { asm volatile("s_waitcnt lgkmcnt(0)" ::: "memory"); __builtin_amdgcn_s_barrier(); } while (0)
  const int nM = M / BM, nN = N / BN, nwg = nM * nN;
  const int tid = c.tid, wid = tid >> 6, lane = tid & 63, wr = wid >> 2, wc = wid & 3, fr = lane & 15, fq = lane >> 4;
  const int nt = K / BK;
  int sR[GLA], sC[GLA];
#pragma unroll
  for (int i = 0; i < GLA; ++i) stage_rc(wid * 1024 + i * 8192 + lane * 16, sR[i], sC[i]);
#define GLDS_STAGE(buf, kt, AP, BP) do { int Kl = K; asm volatile("" : "+s"(Kl)); \
    _Pragma("unroll") for (int i = 0; i < GLA; ++i) \
      __builtin_amdgcn_global_load_lds((const u32*)((AP) + (kt) * BK + (long)i * 64 * Kl), (u32*)(SA(buf) + wid * 1024 + i * 8192), 16, 0, 0); \
    _Pragma("unroll") for (int i = 0; i < GLB; ++i) \
      __builtin_amdgcn_global_load_lds((const u32*)((BP) + (kt) * BK + (long)i * 64 * Kl), (u32*)(SB(buf) + wid * 1024 + i * 8192), 16, 0, 0); } while (0)
#define KHALF(buf, ks, mh) do { bf16x8 At[4]; \
    _Pragma("unroll") for (int m = 0; m < 4; ++m) At[m] = *(const bf16x8*)(SA(buf) + lds_byte(wr * 128 + (mh) * 64 + m * 16 + fr, (ks) * 32 + fq * 8)); \
    _Pragma("unroll") for (int m = 0; m < 4; ++m) _Pragma("unroll") for (int n = 0; n < 4; ++n) \
      acc[(mh) * 4 + m][n] = __builtin_amdgcn_mfma_f32_16x16x32_bf16(Bf[n], At[m], acc[(mh) * 4 + m][n], 0, 0, 0); } while (0)
#define KSTEP(buf, ks) do { bf16x8 Bf[4]; \
    _Pragma("unroll") for (int n = 0; n < 4; ++n) Bf[n] = *(const bf16x8*)(SB(buf) + lds_byte(wc * 64 + n * 16 + fr, (ks) * 32 + fq * 8)); \
    KHALF(buf, ks, 0); KHALF(buf, ks, 1); } while (0)
#define COMPUTE(buf) do { KSTEP(buf, 0); KSTEP(buf, 1); } while (0)

  const int sRb = (sR[0] & ~31) + 8 * ((sR[0] & 15) >> 2) + (sR[0] & 3) + ((sR[0] & 16) ? 4 : 0);
#define TILE_COORDS(wg_, brow_, bcol_) do { int wgid = (wg_); \
    { int q = nwg / NXCD, r = nwg % NXCD, xcd = wgid % NXCD, off = wgid / NXCD; \
      wgid = (xcd < r ? xcd * (q + 1) : r * (q + 1) + (xcd - r) * q) + off; } \
    int nig = WGM * nN, gid = wgid / nig, fm = gid * WGM, gsz = min(nM - fm, WGM); \
    int pm = fm + ((wgid % nig) % gsz), pn = (wgid % nig) / gsz; brow_ = pm * BM; bcol_ = pn * BN; } while (0)
  int wg0 = c.bid;
  bool have = wg0 < nwg;
  int brow = 0, bcol = 0;
  const u16* ap = A; const u16* bp = Bt;
  if (have) {
    TILE_COORDS(wg0, brow, bcol);
    ap = A + (long)brow * K + (long)sR[0] * K + sC[0];
    bp = Bt + (long)bcol * K + (long)sRb * K + sC[0];
    GLDS_STAGE(0, 0, ap, bp);
  }
  while (have) {
    f32x4 acc[8][4];
#pragma unroll
    for (int m = 0; m < 8; ++m)
#pragma unroll
      for (int n = 0; n < 4; ++n) acc[m][n] = f32x4{0.f, 0.f, 0.f, 0.f};
    const int wgn = wg0 + c.nb;
    const bool hn = wgn < nwg;
    int brn = 0, bcn = 0;
    const u16* apn = A; const u16* bpn = Bt;
    if (hn) {
      TILE_COORDS(wgn, brn, bcn);
      apn = A + (long)brn * K + (long)sR[0] * K + sC[0];
      bpn = Bt + (long)bcn * K + (long)sRb * K + sC[0];
    }
    WAIT_V(0); __syncthreads();
#pragma unroll 2
    for (int t = 0; t < nt; ++t) {
      int cur = t & 1;
      if (t + 1 < nt) GLDS_STAGE(cur ^ 1, t + 1, ap, bp);
      else if (hn) GLDS_STAGE(0, 0, apn, bpn);
      COMPUTE(cur);
      if (t + 1 < nt) { WAIT_V(0); __syncthreads(); }
    }
#define EPILOOP(EPI) \
    _Pragma("unroll") for (int m = 0; m < 8; ++m) \
    _Pragma("unroll") for (int n = 0; n < 4; n += 2) \
      EPI(brow + wr * 128 + m * 16 + fr, bcol + wc * 64 + n * 16 + fq * 8, acc[m][n], acc[m][n + 1]);
    if (gd.kind == 0) { EPILOOP(gd.eproj) }
    else if (gd.kind == 1) { EPILOOP(gd.elora) }
    else if (gd.kind == 2) { EPILOOP(gd.eresh) }
    else if (gd.kind == 4) { EPILOOP(gd.eresb) }
    else { EPILOOP(gd.erelu) }
#undef EPILOOP
    wg0 = wgn; have = hn; brow = brn; bcol = bcn; ap = apn; bp = bpn;
  }
#undef TILE_COORDS
#undef SA
#undef SB
#undef GLDS_STAGE
#undef KHALF
#undef KSTEP
#undef COMPUTE
}

__device__ void transpose_convert(const Ctx c, const float* __restrict__ src, u16* __restrict__ dst, int K, int N, int Npad, float* lds) {
  const int tid = c.tid;
  const int tk = K / 64, tn = Npad / 64, ntile = tk * tn;
  for (int t = c.bid; t < ntile; t += c.nb) {
    int k0 = (t % tk) * 64, n0 = (t / tk) * 64;
    __syncthreads();
#pragma unroll
    for (int i = 0; i < 8; ++i) {
      int kk = i * 8 + (tid >> 6), nn = tid & 63;
      float v = (n0 + nn < N) ? __builtin_nontemporal_load(src + (size_t)(k0 + kk) * N + n0 + nn) : 0.f;
      lds[kk * 65 + nn] = v;
    }
    __syncthreads();
#pragma unroll
    for (int i = 0; i < 8; ++i) {
      int nn = i * 8 + (tid >> 6), kk = tid & 63;
      dst[(size_t)(n0 + nn) * K + k0 + kk] = f2bf(lds[kk * 65 + nn]);
    }
  }
}

__device__ void convert_weights(const Ctx c, const PV& p, int l, char* shm) {
  float* lds = (float*)shm;
  transpose_convert(c, p.in(IWIN) + (size_t)l * 1024 * 3344, (u16*)(p.ws() + OFF_WIN), 1024, 3344, NPROJ, lds);
  transpose_convert(c, p.in(IWOUT) + (size_t)l * 1024 * 1024, (u16*)(p.ws() + OFF_WOUT), 1024, 1024, 1024, lds);
  transpose_convert(c, p.in(IWFC) + (size_t)l * 1024 * 4096, (u16*)(p.ws() + OFF_WFC), 1024, 4096, 4096, lds);
  transpose_convert(c, p.in(IWPROJ) + (size_t)l * 4096 * 1024, (u16*)(p.ws() + OFF_WPROJ), 4096, 1024, 1024, lds);
  u16* wl = (u16*)(p.ws() + OFF_WLORA);
  const float* wup = p.in(IWUP) + (size_t)l * 2 * 64 * 512;
  const float* aup = p.in(IAUP) + (size_t)l * 2 * 64 * 512;
  const float* gup = p.in(IGUP) + (size_t)l * 128 * 512;
  for (int idx = c.bid * 512 + c.tid; idx < 2560 * 256; idx += c.nb * 512) {
    int n = idx >> 8, k = idx & 255;
    float v = 0.f;
    if (n < 1024) { if (k < 64) { int d = n >> 9, c = n & 511; v = wup[((size_t)d * 64 + k) * 512 + c]; } }
    else if (n < 2048) { if (k >= 64 && k < 128) { int d = (n - 1024) >> 9, c = n & 511; v = aup[((size_t)d * 64 + (k - 64)) * 512 + c]; } }
    else { if (k >= 128) { int c = n - 2048; v = gup[(size_t)(k - 128) * 512 + c]; } }
    wl[idx] = f2bf(v);
  }
}

__device__ void ln_phase(const Ctx c, const float* __restrict__ src, const float* __restrict__ g, const float* __restrict__ b,
                         float* __restrict__ dstf, u16* __restrict__ dstb) {
  const int wave = c.tid >> 6, lane = c.tid & 63;
  float4 gg[4], bb[4];
#pragma unroll
  for (int i = 0; i < 4; ++i) { gg[i] = ((const float4*)g)[lane + 64 * i]; bb[i] = ((const float4*)b)[lane + 64 * i]; }
  int row = c.bid * 8 + wave;
  float4 v[4], nv[4];
  if (row < MTOK) {
#pragma unroll
    for (int i = 0; i < 4; ++i) v[i] = ldnt16f((const float4*)(src + (size_t)row * DM) + lane + 64 * i);
  }
  for (; row < MTOK; row += c.nb * 8) {
    const int nrow = row + c.nb * 8;
    if (nrow < MTOK) {
#pragma unroll
      for (int i = 0; i < 4; ++i) nv[i] = ldnt16f((const float4*)(src + (size_t)nrow * DM) + lane + 64 * i);
    }
    float sum = 0.f;
#pragma unroll
    for (int i = 0; i < 4; ++i) sum += v[i].x + v[i].y + v[i].z + v[i].w;
    float mean = wave_sum(sum) * (1.f / DM);
    float sq = 0.f;
#pragma unroll
    for (int i = 0; i < 4; ++i) {
      float a = v[i].x - mean, b2 = v[i].y - mean, c2 = v[i].z - mean, d = v[i].w - mean;
      sq += a * a + b2 * b2 + c2 * c2 + d * d;
    }
    float rstd = rsqrtf(wave_sum(sq) * (1.f / DM) + LN_EPS);
#pragma unroll
    for (int i = 0; i < 4; ++i) {
      float4 o;
      o.x = (v[i].x - mean) * rstd * gg[i].x + bb[i].x; o.y = (v[i].y - mean) * rstd * gg[i].y + bb[i].y;
      o.z = (v[i].z - mean) * rstd * gg[i].z + bb[i].z; o.w = (v[i].w - mean) * rstd * gg[i].w + bb[i].w;
      uint2 pk; pk.x = pack2(o.x, o.y); pk.y = pack2(o.z, o.w);
      ((uint2*)((u16*)dstf + (size_t)row * DM))[lane + 64 * i] = pk;
      ((uint2*)(dstb + (size_t)row * DM))[lane + 64 * i] = pk;
    }
#pragma unroll
    for (int i = 0; i < 4; ++i) v[i] = nv[i];
  }
}

__device__ __forceinline__ void unpack8(const uint4& v, float (&f)[8]) {
  f[0] = bflo(v.x); f[1] = bfhi(v.x); f[2] = bflo(v.y); f[3] = bfhi(v.y);
  f[4] = bflo(v.z); f[5] = bfhi(v.z); f[6] = bflo(v.w); f[7] = bfhi(v.w);
}
__device__ __forceinline__ uint4 pack8(const float (&f)[8]) {
  uint4 o; o.x = pack2(f[0], f[1]); o.y = pack2(f[2], f[3]); o.z = pack2(f[4], f[5]); o.w = pack2(f[6], f[7]);
  return o;
}

__device__ void ln_phase_b(const Ctx c, const u16* __restrict__ src, const float* __restrict__ g, const float* __restrict__ b,
                           float* __restrict__ dstf, u16* __restrict__ dstb, bool write_f, bool write_b, bool write_h) {
  const int wave = c.tid >> 6, lane = c.tid & 63;
  float gg[16], bb[16];
#pragma unroll
  for (int i = 0; i < 2; ++i)
#pragma unroll
    for (int e = 0; e < 8; ++e) { gg[8 * i + e] = g[8 * (lane + 64 * i) + e]; bb[8 * i + e] = b[8 * (lane + 64 * i) + e]; }
  int row = c.bid * 8 + wave;
  uint4 v[2], nv[2];
  if (row < MTOK) { v[0] = ldnt16((const uint4*)(src + (size_t)row * DM) + lane); v[1] = ldnt16((const uint4*)(src + (size_t)row * DM) + lane + 64); }
  for (; row < MTOK; row += c.nb * 8) {
    const int nrow = row + c.nb * 8;
    if (nrow < MTOK) { nv[0] = ldnt16((const uint4*)(src + (size_t)nrow * DM) + lane); nv[1] = ldnt16((const uint4*)(src + (size_t)nrow * DM) + lane + 64); }
    float x[16];
    { float t0[8], t1[8]; unpack8(v[0], t0); unpack8(v[1], t1);
#pragma unroll
      for (int e = 0; e < 8; ++e) { x[e] = t0[e]; x[8 + e] = t1[e]; } }
    float sum = 0.f;
#pragma unroll
    for (int e = 0; e < 16; ++e) sum += x[e];
    const float mean = wave_sum(sum) * (1.f / DM);
    float sq = 0.f;
#pragma unroll
    for (int e = 0; e < 16; ++e) { float dlt = x[e] - mean; sq += dlt * dlt; }
    const float rstd = rsqrtf(wave_sum(sq) * (1.f / DM) + LN_EPS);
#pragma unroll
    for (int i = 0; i < 2; ++i) {
      float o[8];
#pragma unroll
      for (int e = 0; e < 8; ++e) o[e] = (x[8 * i + e] - mean) * rstd * gg[8 * i + e] + bb[8 * i + e];
      if (write_f) {
        float4* d = (float4*)(dstf + (size_t)row * DM + 8 * (lane + 64 * i));
        d[0] = make_float4(o[0], o[1], o[2], o[3]); d[1] = make_float4(o[4], o[5], o[6], o[7]);
      }
      if (write_b) ((uint4*)(dstb + (size_t)row * DM))[lane + 64 * i] = pack8(o);
      if (write_h) ((uint4*)((u16*)dstf + (size_t)row * DM))[lane + 64 * i] = pack8(o);
    }
    v[0] = nv[0]; v[1] = nv[1];
  }
}

constexpr int PT = 32, PB = 4;
__device__ __forceinline__ void prep_conv(const PV& p, int l, int tile, int cg) {
  const u16* proj = (const u16*)(p.ws() + OFF_P);
  const uint4 zero4 = make_uint4(0u, 0u, 0u, 0u);
  const int t0 = tile * PT, ts0 = t0 & (SEQ - 1);
  {
      const int c0 = cg * 8;
      const float* cw = p.in(ICONVW) + (size_t)l * 5 * 1024 + c0;
      const float* cb = p.in(ICONVB) + (size_t)l * 1024 + c0;
      float w[5][8], bias[8];
#pragma unroll
      for (int j = 0; j < 5; ++j)
#pragma unroll
        for (int e = 0; e < 8; ++e) w[j][e] = cw[j * 1024 + e];
#pragma unroll
      for (int e = 0; e < 8; ++e) bias[e] = cb[e];
      u16* dst; int dstride;
      if (c0 < 512) { dst = (u16*)(p.ws() + OFF_XS) + c0; dstride = 512; }
      else if (c0 < 768) { dst = (u16*)(p.ws() + OFF_BM) + (c0 - 512); dstride = 256; }
      else { dst = (u16*)(p.ws() + OFF_CM) + (c0 - 768); dstride = 256; }
      const u16* src = proj + (size_t)t0 * NPROJ + 512 + c0;
      uint4 x0, x1, x2, x3;
      x0 = (ts0 >= 2) ? ldnt16(src - 2 * (long)NPROJ) : zero4;
      x1 = (ts0 >= 1) ? ldnt16(src - (long)NPROJ) : zero4;
      x2 = ldnt16(src);
      x3 = ldnt16(src + NPROJ);
      uint4 cur[PB], nxt[PB];
#pragma unroll
      for (int u = 0; u < PB; ++u) cur[u] = (ts0 + u + 2 < SEQ) ? ldnt16(src + (long)(u + 2) * NPROJ) : zero4;
      for (int tb = 0; tb < PT; tb += PB) {
        if (tb + PB < PT) {
#pragma unroll
          for (int u = 0; u < PB; ++u) nxt[u] = (ts0 + tb + PB + u + 2 < SEQ) ? ldnt16(src + (long)(tb + PB + u + 2) * NPROJ) : zero4;
        }
#pragma unroll
        for (int u = 0; u < PB; ++u) {
          const uint4 x4 = cur[u];
          float f0[8], f1[8], f2[8], f3[8], f4[8], o[8];
          unpack8(x0, f0); unpack8(x1, f1); unpack8(x2, f2); unpack8(x3, f3); unpack8(x4, f4);
#pragma unroll
          for (int e = 0; e < 8; ++e) {
            float a = bias[e] + w[0][e] * f0[e] + w[1][e] * f1[e] + w[2][e] * f2[e] + w[3][e] * f3[e] + w[4][e] * f4[e];
            o[e] = siluf_(a);
          }
          *(uint4*)(dst + (size_t)(t0 + tb + u) * dstride) = pack8(o);
          x0 = x1; x1 = x2; x2 = x3; x3 = x4;
        }
#pragma unroll
        for (int u = 0; u < PB; ++u) cur[u] = nxt[u];
      }
  }
}

__device__ __forceinline__ void prep_rw(const PV& p, int l, int tile, int rg) {
  const u16* proj = (const u16*)(p.ws() + OFF_P);
  const uint4 zero4 = make_uint4(0u, 0u, 0u, 0u);
  const int t0 = tile * PT, ts0 = t0 & (SEQ - 1);
  {
      const int c0 = rg * 8;
      const float* mup = p.in(IMU) + (size_t)l * 1792 + c0;
      float mu[8], kkc[8];
#pragma unroll
      for (int e = 0; e < 8; ++e) mu[e] = mup[e];
      const bool isk = (rg >= 64 && rg < 128);
      if (isk) {
#pragma unroll
        for (int e = 0; e < 8; ++e) kkc[e] = p.in(IKK)[(size_t)l * 512 + (c0 - 512) + e];
      } else {
#pragma unroll
        for (int e = 0; e < 8; ++e) kkc[e] = 0.f;
      }
      u16* dst; int dstride;
      if (rg < 64) { dst = (u16*)(p.ws() + OFF_R) + c0; dstride = 512; }
      else if (rg < 128) { dst = (u16*)(p.ws() + OFF_K) + (c0 - 512); dstride = 512; }
      else if (rg < 192) { dst = (u16*)(p.ws() + OFF_V) + (c0 - 1024); dstride = 512; }
      else { dst = (u16*)(p.ws() + OFF_S) + (c0 - 1536); dstride = 256; }
      float* invn = (float*)(p.ws() + OFF_INVN);
      const u16* src = proj + (size_t)t0 * NPROJ + SSD_COLS + c0;
      uint4 xm, x0;
      xm = (ts0 >= 1) ? ldnt16(src - (long)NPROJ) : zero4;
      x0 = ldnt16(src);
      uint4 cur[PB], nxt[PB];
#pragma unroll
      for (int u = 0; u < PB; ++u) cur[u] = (ts0 + u + 1 < SEQ) ? ldnt16(src + (long)(u + 1) * NPROJ) : zero4;
      for (int tb = 0; tb < PT; tb += PB) {
        if (tb + PB < PT) {
#pragma unroll
          for (int u = 0; u < PB; ++u) nxt[u] = (ts0 + tb + PB + u + 1 < SEQ) ? ldnt16(src + (long)(tb + PB + u + 1) * NPROJ) : zero4;
        }
#pragma unroll
        for (int u = 0; u < PB; ++u) {
          const uint4 xp = cur[u];
          const int t = tb + u;
          float fm[8], f0[8], fp[8], o[8];
          unpack8(xm, fm); unpack8(x0, f0); unpack8(xp, fp);
#pragma unroll
          for (int e = 0; e < 8; ++e) o[e] = f0[e] + (0.5f * (fm[e] + fp[e]) - f0[e]) * mu[e];
          if (rg >= 192) {
            if (rg < 200) {
#pragma unroll
              for (int e = 0; e < 8; ++e) o[e] = tanhf_(o[e]);
            } else if (rg >= 208) {
#pragma unroll
              for (int e = 0; e < 8; ++e) o[e] = sigmoidf_(o[e]);
            }
          }
          const uint4 ov = pack8(o);
          *(uint4*)(dst + (size_t)(t0 + t) * dstride) = ov;
          if (isk) {
            float kr[8]; unpack8(ov, kr);
            float ss = 0.f;
#pragma unroll
            for (int e = 0; e < 8; ++e) { float qv = kr[e] * kkc[e]; ss += qv * qv; }
            ss += __shfl_xor(ss, 1); ss += __shfl_xor(ss, 2); ss += __shfl_xor(ss, 4);
            if ((rg & 7) == 0) invn[(size_t)(t0 + t) * 8 + ((rg - 64) >> 3)] = 1.f / fmaxf(sqrtf(ss), 1e-12f);
          }
          xm = x0; x0 = xp;
        }
#pragma unroll
        for (int u = 0; u < PB; ++u) cur[u] = nxt[u];
      }
  }
}

__device__ __forceinline__ void prep_z(const PV& p, int l, int tile, int zg) {
  const u16* proj = (const u16*)(p.ws() + OFF_P);
  const uint4 zero4 = make_uint4(0u, 0u, 0u, 0u);
  const int t0 = tile * PT, ts0 = t0 & (SEQ - 1);
  {
      const int c0 = zg * 8;
      const u16* src = proj + (size_t)t0 * NPROJ + c0;
      u16* dst = (u16*)(p.ws() + OFF_SZ) + c0;
      for (int tb = 0; tb < PT; tb += PB) {
        uint4 xx[PB];
#pragma unroll
        for (int u = 0; u < PB; ++u) xx[u] = ldnt16(src + (long)(tb + u) * NPROJ);
#pragma unroll
        for (int u = 0; u < PB; ++u) {
          float f[8], o[8]; unpack8(xx[u], f);
#pragma unroll
          for (int e = 0; e < 8; ++e) o[e] = siluf_(f[e]);
          *(uint4*)(dst + (size_t)(t0 + tb + u) * 512) = pack8(o);
        }
      }
  }
}

__device__ void prep_phase(const Ctx c, const PV& p, int l) {
  const int tid = c.tid;
  constexpr int NT = MTOK / PT;
  for (int g = c.bid; g < NT / 4; g += c.nb) prep_conv(p, l, g * 4 + (tid >> 7), tid & 127);
  for (int g = c.bid; g < NT / 2; g += c.nb) { const int rg = tid & 255; if (rg < 224) prep_rw(p, l, g * 2 + (tid >> 8), rg); }
  for (int g = c.bid; g < NT / 8; g += c.nb) prep_z(p, l, g * 8 + (tid >> 6), tid & 63);
  {
    const float* dtraw = (const float*)(p.ws() + OFF_DTRAW);
    float* dt = (float*)(p.ws() + OFF_DT);
    float xv[4];
#pragma unroll
    for (int u = 0; u < 4; ++u) xv[u] = dtraw[(size_t)(u * c.nb + c.bid) * 512 + tid];
    const float bia = p.in(IDTB)[(size_t)l * 16 + (tid & 15)];
#pragma unroll
    for (int u = 0; u < 4; ++u) dt[(size_t)(u * c.nb + c.bid) * 512 + tid] = softplusf_(xv[u] + bia);
  }
}

__device__ __forceinline__ float rowsum4(float x) {
  auto r = __builtin_amdgcn_permlane16_swap(__float_as_uint(x), __float_as_uint(x), false, false);
  float y = __uint_as_float(r[0]) + __uint_as_float(r[1]);
  auto r2 = __builtin_amdgcn_permlane32_swap(__float_as_uint(y), __float_as_uint(y), false, false);
  return __uint_as_float(r2[0]) + __uint_as_float(r2[1]);
}

#define DPPB(I) " row_newbcast:" #I " row_mask:0xf bank_mask:0xf\n"

__device__ __forceinline__ float dot16(const float (&S)[16], float vec) {
  float acc;
  asm volatile("s_nop 1\n"
      "v_mul_f32_dpp %0, %17, %1" DPPB(0)
      "v_fmac_f32_dpp %0, %17, %2" DPPB(1)
      "v_fmac_f32_dpp %0, %17, %3" DPPB(2)
      "v_fmac_f32_dpp %0, %17, %4" DPPB(3)
      "v_fmac_f32_dpp %0, %17, %5" DPPB(4)
      "v_fmac_f32_dpp %0, %17, %6" DPPB(5)
      "v_fmac_f32_dpp %0, %17, %7" DPPB(6)
      "v_fmac_f32_dpp %0, %17, %8" DPPB(7)
      "v_fmac_f32_dpp %0, %17, %9" DPPB(8)
      "v_fmac_f32_dpp %0, %17, %10" DPPB(9)
      "v_fmac_f32_dpp %0, %17, %11" DPPB(10)
      "v_fmac_f32_dpp %0, %17, %12" DPPB(11)
      "v_fmac_f32_dpp %0, %17, %13" DPPB(12)
      "v_fmac_f32_dpp %0, %17, %14" DPPB(13)
      "v_fmac_f32_dpp %0, %17, %15" DPPB(14)
      "v_fmac_f32_dpp %0, %17, %16" DPPB(15)
      : "=&v"(acc)
      : "v"(S[0]), "v"(S[1]), "v"(S[2]), "v"(S[3]), "v"(S[4]), "v"(S[5]), "v"(S[6]), "v"(S[7]),
        "v"(S[8]), "v"(S[9]), "v"(S[10]), "v"(S[11]), "v"(S[12]), "v"(S[13]), "v"(S[14]), "v"(S[15]), "v"(vec));
  return acc;
}

#define UPD(I, SI) \
      "v_mul_f32_dpp " SI ", %16, " SI DPPB(I) \
      "v_fmac_f32_dpp " SI ", %17, %19" DPPB(I) \
      "v_fmac_f32_dpp " SI ", %18, %20" DPPB(I)
__device__ __forceinline__ void update16(float (&S)[16], float w, float b, float kd, float nskk, float vv) {
  asm volatile("s_nop 1\n"
      UPD(0, "%0") UPD(1, "%1") UPD(2, "%2") UPD(3, "%3") UPD(4, "%4") UPD(5, "%5") UPD(6, "%6") UPD(7, "%7")
      UPD(8, "%8") UPD(9, "%9") UPD(10, "%10") UPD(11, "%11") UPD(12, "%12") UPD(13, "%13") UPD(14, "%14") UPD(15, "%15")
      : "+v"(S[0]), "+v"(S[1]), "+v"(S[2]), "+v"(S[3]), "+v"(S[4]), "+v"(S[5]), "+v"(S[6]), "+v"(S[7]),
        "+v"(S[8]), "+v"(S[9]), "+v"(S[10]), "+v"(S[11]), "+v"(S[12]), "+v"(S[13]), "+v"(S[14]), "+v"(S[15])
      : "v"(w), "v"(b), "v"(kd), "v"(nskk), "v"(vv));
}

typedef float f32x2 __attribute__((ext_vector_type(2)));
constexpr int RB = 16;
constexpr int RW_STEP = 1536;
constexpr int RW_OFF = 90112;
constexpr int RW_CNT = RW_OFF + 2 * RB * RW_STEP;
constexpr int RW_YBUF = 139520;
constexpr int XB_LDS_OFF = 147456;

__device__ __forceinline__ void group_barrier(int* cnt, int& gen, int lane);

__device__ void rwkv_scan(const PV& p, int l, int item, int tid  , char* shm, int& gen) {
  const int d = item >> 7, b = (item >> 3) & 15, h = item & 7;
  const int j = tid >> 6, lane = tid & 63, vl = lane & 15, q = lane >> 4;
  const u16* rr = (const u16*)(p.ws() + OFF_R); const u16* kk_ = (const u16*)(p.ws() + OFF_K); const u16* vv_ = (const u16*)(p.ws() + OFF_V);
  const u16* ee = (const u16*)(p.ws() + OFF_E) + (size_t)d * MTOK * 512;
  const u16* aa = (const u16*)(p.ws() + OFF_A) + (size_t)d * MTOK * 512;
  const float* invn = (const float*)(p.ws() + OFF_INVN);
  u16* yr = (u16*)(p.ws() + OFF_YR) + (size_t)d * MTOK * 512;
  int* cnt = (int*)(shm + RW_CNT);
  const int ch = h * 64 + lane, chv = h * 64 + 16 * j + vl;
  const float kkc = p.in(IKK)[(size_t)l * 512 + ch];
  const float ka = p.in(IKA)[(size_t)l * 512 + ch];
  const long tok0 = (long)b * SEQ + (d ? SEQ - 1 : 0);
  const long dstep = d ? -1 : 1;

  u16 gr[4], gk[4], ge[4], ga[4], gv[4]; float gi[4];
#define RW_LOAD(n) do { _Pragma("unroll") for (int s = 0; s < 4; ++s) { \
      long tok = tok0 + dstep * ((n) * RB + 4 * j + s); \
      gr[s] = rr[tok * 512 + ch]; gk[s] = kk_[tok * 512 + ch]; ge[s] = __builtin_nontemporal_load(ee + tok * 512 + ch); ga[s] = __builtin_nontemporal_load(aa + tok * 512 + ch); \
      gv[s] = vv_[tok * 512 + ch]; gi[s] = invn[tok * 8 + h]; } } while (0)
#define RW_WRITE(n) do { _Pragma("unroll") for (int s = 0; s < 4; ++s) { \
      float* dst = (float*)(shm + RW_OFF + ((n) & 1) * RB * RW_STEP + (4 * j + s) * RW_STEP); \
      float r = bf2f(gr[s]), k = bf2f(gk[s]), e = bf2f(ge[s]), a = bf2f(ga[s]); \
      float kkv = k * kkc * gi[s]; \
      dst[lane] = kkv; dst[64 + lane] = __expf(-e); dst[128 + lane] = kkv * a; \
      dst[192 + lane] = k * (1.f + (a - 1.f) * ka); dst[256 + lane] = r; dst[320 + lane] = bf2f(gv[s]); } } while (0)

  const int q8 = lane >> 3, rp = lane & 7;
  float S0[8], S1[8];
#pragma unroll
  for (int i = 0; i < 8; ++i) { S0[i] = 0.f; S1[i] = 0.f; }
#define FMAC(acc, a, b) acc = __builtin_fmaf(a, b, acc)
#define FMUL(dst, a, b) dst = (a) * (b)
#define REDUCE2(x0, x1, t0, t1) do { \
    float _a = x0 + __builtin_bit_cast(float, __builtin_amdgcn_update_dpp(0, __builtin_bit_cast(int, x0), 0x128, 0xf, 0xf, false)); \
    float _b = x1 + __builtin_bit_cast(float, __builtin_amdgcn_update_dpp(0, __builtin_bit_cast(int, x1), 0x128, 0xf, 0xf, false)); \
    auto _r = __builtin_amdgcn_permlane16_swap(__float_as_uint(_a), __float_as_uint(_b), false, false); \
    float _c = __uint_as_float(_r[0]) + __uint_as_float(_r[1]); \
    auto _r2 = __builtin_amdgcn_permlane32_swap(__float_as_uint(_c), __float_as_uint(_c), false, false); \
    float _d = __uint_as_float(_r2[0]) + __uint_as_float(_r2[1]); \
    auto _r3 = __builtin_amdgcn_permlane16_swap(__float_as_uint(_d), __float_as_uint(_d), false, false); \
    t0 = __uint_as_float(_r3[0]); t1 = __uint_as_float(_r3[1]); } while (0)
  u32* ybuf = (u32*)(shm + RW_YBUF) + j * (RB * 8);
  RW_LOAD(0); RW_WRITE(0);
  group_barrier(cnt, gen, lane);
  for (int n = 0; n < SEQ / RB; ++n) {
    if (n + 1 < SEQ / RB) RW_LOAD(n + 1);
    int boff = RW_OFF + (n & 1) * RB * RW_STEP + q8 * 32;
    asm volatile("" : "+v"(boff));
    const char* bufb = shm + boff;
    const int voff = 1280 - q8 * 32 + (16 * j + 2 * rp) * 4;
    f32x4 k4[2]; f32x2 vv;
    k4[0] = ((const f32x4*)bufb)[0]; k4[1] = ((const f32x4*)bufb)[1];
    vv = *(const f32x2*)(bufb + voff);
#pragma unroll
    for (int s = 0; s < RB; ++s) {
      const f32x4* P = (const f32x4*)(bufb + s * RW_STEP);
      f32x4 w4[2], b4[2], d4[2], r4[2];
#pragma unroll
      for (int i = 0; i < 2; ++i) { w4[i] = P[16 + i]; b4[i] = P[32 + i]; d4[i] = P[48 + i]; r4[i] = P[64 + i]; }
      float a0, a1;
      FMUL(a0, S0[0], k4[0][0]); FMUL(a1, S1[0], k4[0][0]);
#pragma unroll
      for (int i = 1; i < 8; ++i) { FMAC(a0, S0[i], k4[i >> 2][i & 3]); FMAC(a1, S1[i], k4[i >> 2][i & 3]); }
      float t0, t1;
      REDUCE2(a0, a1, t0, t1);
      const float ns0 = -t0, ns1 = -t1;
      const float v0 = vv[0], v1 = vv[1];
      if (s + 1 < RB) {
        k4[0] = ((const f32x4*)(bufb + (s + 1) * RW_STEP))[0]; k4[1] = ((const f32x4*)(bufb + (s + 1) * RW_STEP))[1];
        vv = *(const f32x2*)(bufb + (s + 1) * RW_STEP + voff);
      }
#pragma unroll
      for (int i = 0; i < 8; ++i) {
        FMUL(S0[i], S0[i], w4[i >> 2][i & 3]); FMUL(S1[i], S1[i], w4[i >> 2][i & 3]);
        FMAC(S0[i], ns0, b4[i >> 2][i & 3]);   FMAC(S1[i], ns1, b4[i >> 2][i & 3]);
        FMAC(S0[i], v0, d4[i >> 2][i & 3]);    FMAC(S1[i], v1, d4[i >> 2][i & 3]);
      }
      float y0, y1;
      FMUL(y0, S0[0], r4[0][0]); FMUL(y1, S1[0], r4[0][0]);
#pragma unroll
      for (int i = 1; i < 8; ++i) { FMAC(y0, S0[i], r4[i >> 2][i & 3]); FMAC(y1, S1[i], r4[i >> 2][i & 3]); }
      float yt0, yt1;
      REDUCE2(y0, y1, yt0, yt1);
      ybuf[s * 8 + rp] = pack2(yt0, yt1);
    }
    asm volatile("s_waitcnt lgkmcnt(0)" ::: "memory");
#pragma unroll
    for (int u = 0; u < 2; ++u) {
      const int s = (lane >> 3) + 8 * u;
      *(u32*)(yr + (tok0 + dstep * (n * RB + s)) * 512 + h * 64 + 16 * j + 2 * rp) = ybuf[s * 8 + rp];
    }
    if (n + 1 < SEQ / RB) RW_WRITE(n + 1);
    group_barrier(cnt, gen, lane);
  }
#undef REDUCE2
#undef FMAC
#undef FMUL
#undef RW_LOAD
#undef RW_WRITE
}

__device__ __forceinline__ void group_barrier(int* cnt, int& gen, int lane) {
  __builtin_amdgcn_fence(__ATOMIC_RELEASE, "workgroup");
  gen += 4;
  if (lane == 0) __hip_atomic_fetch_add(cnt, 1, __ATOMIC_RELAXED, __HIP_MEMORY_SCOPE_WORKGROUP);
  while (__hip_atomic_load(cnt, __ATOMIC_RELAXED, __HIP_MEMORY_SCOPE_WORKGROUP) < gen) __builtin_amdgcn_s_sleep(1);
  __builtin_amdgcn_fence(__ATOMIC_ACQUIRE, "workgroup");
}

constexpr int LC = 64;
constexpr int ST128 = 136, ST64 = 72;
constexpr int SSD_SC = 0, SSD_SB = 17408, SSD_SBT = 34816, SSD_SXT = 53248, SSD_SM = 62464, SSD_SH = 71680, SSD_CNT = 89088;

__device__ void ssd_item(const PV& p, int l, int item, int tid  , char* shm, int& gen) {
  const int d = item >> 7, b = (item >> 3) & 15, h = item & 7, g = h >> 2;
  const int w4 = tid >> 6, lane = tid & 63, wr = w4 >> 1, wc = w4 & 1, l31 = lane & 31, hi = lane >> 5;
  u16* sC = (u16*)(shm + SSD_SC); u16* sB = (u16*)(shm + SSD_SB); u16* sBT = (u16*)(shm + SSD_SBT);
  u16* sXT = (u16*)(shm + SSD_SXT); u16* sM = (u16*)(shm + SSD_SM); u16* sH = (u16*)(shm + SSD_SH);
  int* cnt = (int*)(shm + SSD_CNT);
  const u16* xs = (const u16*)(p.ws() + OFF_XS); const u16* Bm = (const u16*)(p.ws() + OFF_BM); const u16* Cm = (const u16*)(p.ws() + OFF_CM);
  const float* dt = (const float*)(p.ws() + OFF_DT);
  u16* ys = (u16*)(p.ws() + OFF_S) + (size_t)d * MTOK * 512;
  const float Aneg = -__expf(p.in(IALOG)[l * 16 + d * 8 + h]);
  for (int i = tid; i < 64 * ST128 / 2; i += 256) ((u32*)sH)[i] = 0u;
  f32x16 Hacc[2];
#pragma unroll
  for (int i = 0; i < 16; ++i) { Hacc[0][i] = 0.f; Hacc[1][i] = 0.f; }

  for (int ci = 0; ci < SEQ / LC; ++ci) {
    const int c = d ? (SEQ / LC - 1 - ci) : ci;
    const long tokbase = (long)b * SEQ + c * LC;
#define TOK(lr) (tokbase + (d ? (LC - 1 - (lr)) : (lr)))
    const float dtv = dt[TOK(lane) * 16 + d * 8 + h];
    float cs = dtv * Aneg;
#pragma unroll
    for (int o = 1; o < 64; o <<= 1) { float t = __shfl_up(cs, o); if (lane >= o) cs += t; }
    const float cs_last = __shfl(cs, 63);
#pragma unroll
    for (int i = 0; i < 4; ++i) {
      int idx = tid + 256 * i, row = idx & 63, seg = idx >> 6;
      long tk = TOK(row);
      uint4 cvv = *(const uint4*)(Cm + tk * 256 + g * 128 + seg * 8);
      uint4 bvv = *(const uint4*)(Bm + tk * 256 + g * 128 + seg * 8);
      *(uint4*)(sC + row * ST128 + seg * 8) = cvv;
      *(uint4*)(sB + row * ST128 + seg * 8) = bvv;
      float dec = __expf(cs_last - cs);
      u32 bw[4] = {bvv.x, bvv.y, bvv.z, bvv.w};
#pragma unroll
      for (int q = 0; q < 4; ++q) {
        sBT[(seg * 8 + 2 * q) * ST64 + row] = f2bf(bflo(bw[q]) * dec);
        sBT[(seg * 8 + 2 * q + 1) * ST64 + row] = f2bf(bfhi(bw[q]) * dec);
      }
    }
#pragma unroll
    for (int i = 0; i < 2; ++i) {
      int idx = tid + 256 * i, row = idx & 63, seg = idx >> 6;
      long tk = TOK(row);
      uint4 xv = *(const uint4*)(xs + tk * 512 + h * 64 + seg * 8);
      float dts = dtv;
      u32 xw[4] = {xv.x, xv.y, xv.z, xv.w};
#pragma unroll
      for (int q = 0; q < 4; ++q) {
        sXT[(seg * 8 + 2 * q) * ST64 + row] = f2bf(bflo(xw[q]) * dts);
        sXT[(seg * 8 + 2 * q + 1) * ST64 + row] = f2bf(bfhi(xw[q]) * dts);
      }
    }
    group_barrier(cnt, gen, lane);
    {
      f32x16 acc;
#pragma unroll
      for (int i = 0; i < 16; ++i) acc[i] = 0.f;
#pragma unroll
      for (int kb = 0; kb < 8; ++kb) {
        bf16x8 a = *(const bf16x8*)(sC + (32 * wr + l31) * ST128 + kb * 16 + hi * 8);
        bf16x8 bb = *(const bf16x8*)(sB + (32 * wc + l31) * ST128 + kb * 16 + hi * 8);
        acc = __builtin_amdgcn_mfma_f32_32x32x16_bf16(a, bb, acc, 0, 0, 0);
      }
      const int s = 32 * wc + l31;
      const float cs_s = __shfl(cs, s);
#pragma unroll
      for (int i = 0; i < 16; ++i) {
        int lrow = 32 * wr + 8 * (i >> 2) + 4 * hi + (i & 3);
        const int lr0 = 32 * wr + 8 * (i >> 2) + (i & 3);
        float cs_l = __uint_as_float(hi ? __builtin_amdgcn_readlane(__float_as_uint(cs), lr0 + 4) : __builtin_amdgcn_readlane(__float_as_uint(cs), lr0));
        float m = (s <= lrow) ? acc[i] * __expf(cs_l - cs_s) : 0.f;
        sM[lrow * ST64 + s] = f2bf(m);
      }
    }
    group_barrier(cnt, gen, lane);
    {
      f32x16 acc1, acc2;
#pragma unroll
      for (int i = 0; i < 16; ++i) { acc1[i] = 0.f; acc2[i] = 0.f; }
#pragma unroll
      for (int kb = 0; kb < 4; ++kb) {
        bf16x8 a = *(const bf16x8*)(sM + (32 * wr + l31) * ST64 + kb * 16 + hi * 8);
        bf16x8 bb = *(const bf16x8*)(sXT + (32 * wc + l31) * ST64 + kb * 16 + hi * 8);
        acc1 = __builtin_amdgcn_mfma_f32_32x32x16_bf16(a, bb, acc1, 0, 0, 0);
      }
#pragma unroll
      for (int kb = 0; kb < 8; ++kb) {
        bf16x8 a = *(const bf16x8*)(sC + (32 * wr + l31) * ST128 + kb * 16 + hi * 8);
        bf16x8 bb = *(const bf16x8*)(sH + (32 * wc + l31) * ST128 + kb * 16 + hi * 8);
        acc2 = __builtin_amdgcn_mfma_f32_32x32x16_bf16(a, bb, acc2, 0, 0, 0);
      }
      const int pcol = h * 64 + 32 * wc + l31;
#pragma unroll
      for (int i = 0; i < 16; ++i) {
        int lrow = 32 * wr + 8 * (i >> 2) + 4 * hi + (i & 3);
        const int lr0 = 32 * wr + 8 * (i >> 2) + (i & 3);
        const float cs_l = __uint_as_float(hi ? __builtin_amdgcn_readlane(__float_as_uint(cs), lr0 + 4) : __builtin_amdgcn_readlane(__float_as_uint(cs), lr0));
        float y = acc1[i] + __expf(cs_l) * acc2[i];
        ys[TOK(lrow) * 512 + pcol] = f2bf(y);
      }
    }
    group_barrier(cnt, gen, lane);
    {
      const float dall = __expf(cs_last);
#pragma unroll
      for (int nt = 0; nt < 2; ++nt) {
#pragma unroll
        for (int i = 0; i < 16; ++i) Hacc[nt][i] *= dall;
#pragma unroll
        for (int kb = 0; kb < 4; ++kb) {
          bf16x8 a = *(const bf16x8*)(sXT + (32 * wr + l31) * ST64 + kb * 16 + hi * 8);
          bf16x8 bb = *(const bf16x8*)(sBT + (64 * wc + 32 * nt + l31) * ST64 + kb * 16 + hi * 8);
          Hacc[nt] = __builtin_amdgcn_mfma_f32_32x32x16_bf16(a, bb, Hacc[nt], 0, 0, 0);
        }
#pragma unroll
        for (int i = 0; i < 16; ++i) {
          int prow = 32 * wr + 8 * (i >> 2) + 4 * hi + (i & 3);
          sH[prow * ST128 + 64 * wc + 32 * nt + l31] = f2bf(Hacc[nt][i]);
        }
      }
    }
    group_barrier(cnt, gen, lane);
#undef TOK
  }
}

__device__ void mixer_phase(const Ctx c, const PV& p, int l, char* shm) {
  int* cnt = (int*)(shm + SSD_CNT);
  int* cnt2 = (int*)(shm + RW_CNT);
  if (c.tid == 0) { *cnt = 0; *cnt2 = 0; }
  __syncthreads();
  int gen = 0;
  if (c.tid < 256) {
    for (int rep = 0; rep < ((PROBE_MIX & 1) ? 2 : 1); ++rep)
    for (int it = c.bid; it < 256; it += c.nb) rwkv_scan(p, l, it, c.tid, shm, gen);
  } else {
    for (int rep = 0; rep < ((PROBE_MIX & 2) ? 2 : 1); ++rep)
    for (int it = c.bid; it < 256; it += c.nb) ssd_item(p, l, it, c.tid - 256, shm, gen);
  }
}

__device__ void post_phase(const Ctx c, const PV& p, int l) {
  const int wave = c.tid >> 6, lane = c.tid & 63;
  const u16* xs = (const u16*)(p.ws() + OFF_XS); const u16* sz = (const u16*)(p.ws() + OFF_SZ);
  const u16* ys = (const u16*)(p.ws() + OFF_S);
  const u16* yr = (const u16*)(p.ws() + OFF_YR);
  const u16* rr = (const u16*)(p.ws() + OFF_R); const u16* kk_ = (const u16*)(p.ws() + OFF_K); const u16* vv = (const u16*)(p.ws() + OFF_V);
  const u16* aa = (const u16*)(p.ws() + OFF_A); const u16* gg = (const u16*)(p.ws() + OFF_G);
  u16* ymix = (u16*)(p.ws() + OFF_YMIX);
  const float* dskip = p.in(IDSKIP) + l * 8;
  const float* ng = p.in(ISSDG) + (size_t)l * 512;
  const float* ka = p.in(IKA) + (size_t)l * 512; const float* rk = p.in(IRK) + (size_t)l * 512;
  const float* lg = p.in(ILNXG) + (size_t)l * 512; const float* lb = p.in(ILNXB) + (size_t)l * 512;
  const int c0 = lane * 8;
  float ngv[8], kav[8], rkv[8], lgv[8], lbv[8];
#pragma unroll
  for (int e = 0; e < 8; ++e) { ngv[e] = ng[c0 + e]; kav[e] = ka[c0 + e]; rkv[e] = rk[c0 + e]; lgv[e] = lg[c0 + e]; lbv[e] = lb[c0 + e]; }
  const float ds = dskip[lane >> 3];
#define POST_LOAD(D, tok_) do { const size_t o_ = (size_t)(tok_) * 512 + c0; \
    D[0] = ldnt16(ys + o_); D[1] = ldnt16(ys + (size_t)MTOK * 512 + o_); \
    D[2] = ldnt16(xs + o_); D[3] = ldnt16(sz + o_); \
    D[4] = ldnt16(yr + o_); D[5] = ldnt16(yr + (size_t)MTOK * 512 + o_); \
    D[6] = ldnt16(rr + o_); D[7] = ldnt16(kk_ + o_); D[8] = ldnt16(vv + o_); D[9] = ldnt16(gg + o_); \
    D[10] = ldnt16(aa + o_); D[11] = ldnt16(aa + (size_t)MTOK * 512 + o_); } while (0)
  int tok = c.bid * 8 + wave;
  uint4 L[12], N[12];
  if (tok < MTOK) POST_LOAD(L, tok);
  for (; tok < MTOK; tok += c.nb * 8) {
    const int ntok = tok + c.nb * 8;
    if (ntok < MTOK) POST_LOAD(N, ntok);
    {
      float f[8], bk[8], x[8], z[8];
      unpack8(L[0], f); unpack8(L[1], bk); unpack8(L[2], x); unpack8(L[3], z);
      float y[8]; float ss = 0.f;
#pragma unroll
      for (int e = 0; e < 8; ++e) { y[e] = (f[e] + bk[e] + ds * x[e]) * z[e]; ss += y[e] * y[e]; }
#pragma unroll
      for (int off = 16; off >= 1; off >>= 1) ss += __shfl_xor(ss, off);
      const float rs = rsqrtf(ss * (1.f / 256.f) + RMS_EPS);
      float ov[8];
#pragma unroll
      for (int e = 0; e < 8; ++e) ov[e] = y[e] * rs * ngv[e];
      *(uint4*)(ymix + (size_t)tok * 1024 + c0) = pack8(ov);
    }
    {
      float yf[8], yb[8], r[8], k[8], vf[8], gf[8], af[8], ab[8];
      unpack8(L[4], yf); unpack8(L[5], yb); unpack8(L[6], r); unpack8(L[7], k); unpack8(L[8], vf); unpack8(L[9], gf);
      unpack8(L[10], af); unpack8(L[11], ab);
      float y[8]; float sum = 0.f, bon = 0.f;
#pragma unroll
      for (int e = 0; e < 8; ++e) {
        y[e] = yf[e] + yb[e]; sum += y[e];
        bon += r[e] * k[e] * rkv[e] * (2.f + (af[e] + ab[e] - 2.f) * kav[e]);
      }
#pragma unroll
      for (int off = 4; off >= 1; off >>= 1) { sum += __shfl_xor(sum, off); bon += __shfl_xor(bon, off); }
      const float mean = sum * (1.f / 64.f);
      float sq = 0.f;
#pragma unroll
      for (int e = 0; e < 8; ++e) { float dlt = y[e] - mean; sq += dlt * dlt; }
#pragma unroll
      for (int off = 4; off >= 1; off >>= 1) sq += __shfl_xor(sq, off);
      const float rstd = rsqrtf(sq * (1.f / 64.f) + GN_EPS);
      float ov[8];
#pragma unroll
      for (int e = 0; e < 8; ++e) ov[e] = ((y[e] - mean) * rstd * lgv[e] + lbv[e] + bon * vf[e]) * gf[e];
      *(uint4*)(ymix + (size_t)tok * 1024 + 512 + c0) = pack8(ov);
    }
#pragma unroll
    for (int i = 0; i < 12; ++i) L[i] = N[i];
  }
#undef POST_LOAD
}

#define XB_TMO      128
#define XB_XCNT(j)  (256  + 64 * (j))
#define XB_XSUB(j)  (1280 + 64 * (j))
#define XB_XGEN(j)  (2304 + 64 * (j))
#define XB_TOP      3328
#define XB_TOPGEN   3392
#define XCD_BAR_WORDS 3456
#define XB_SPIN_CAP (1u << 18)
#define LAS __attribute__((address_space(3)))

__device__ __forceinline__ unsigned xb_ld(unsigned* p)              { return __hip_atomic_load(p, __ATOMIC_RELAXED, __HIP_MEMORY_SCOPE_AGENT); }
__device__ __forceinline__ unsigned xb_add(unsigned* p, unsigned v) { return __hip_atomic_fetch_add(p, v, __ATOMIC_RELAXED, __HIP_MEMORY_SCOPE_AGENT); }
__device__ __forceinline__ unsigned xb_xcc_id() { return (unsigned)__builtin_amdgcn_s_getreg((3 << 11) | 20) & 0xFu; }
#define XB_SPIN(cond, bar) do { unsigned _sp = 0; while (cond) { __builtin_amdgcn_s_sleep(1); \
    if ((++_sp & 255u) == 0u) { if (xb_ld(&(bar)[XB_TMO])) break; if (_sp > XB_SPIN_CAP) { atomicAdd(&(bar)[XB_TMO], 1u); break; } } } } while (0)

struct XcdBarrier {
    unsigned* bar; unsigned x; unsigned wv;
    volatile LAS unsigned* st;
};

__device__ __forceinline__ XcdBarrier xcd_barrier_post(unsigned* bar, volatile LAS unsigned* st) {
    XcdBarrier b; b.bar = bar; b.x = xb_xcc_id(); b.st = st; b.wv = (unsigned)__builtin_amdgcn_readfirstlane((int)(threadIdx.x >> 6));
    if (threadIdx.x == 0) (void)xb_add(&bar[XB_XCNT(b.x)], 1u);
    return b;
}
__device__ __forceinline__ void xcd_barrier_complete(unsigned* bar, unsigned x, unsigned& nloc, unsigned& nx) {
    const unsigned G = gridDim.x * gridDim.y * gridDim.z;
    unsigned sum, cnt, mine, sp = 0u;
    for (;;) {
        sum = 0u; cnt = 0u; mine = 0u;
#pragma unroll
        for (unsigned j = 0; j < 16; ++j) { const unsigned c = xb_ld(&bar[XB_XCNT(j)]); sum += c; cnt += (c > 0u) ? 1u : 0u; mine = (j == x) ? c : mine; }
        if (sum == G) break;
        __builtin_amdgcn_s_sleep(1);
        if ((++sp & 255u) == 0u) { if (xb_ld(&bar[XB_TMO])) break; if (sp > XB_SPIN_CAP) { atomicAdd(&bar[XB_TMO], 1u); break; } }
    }
    nloc = mine > 0u ? mine : 1u; nx = cnt > 0u ? cnt : 1u;
}

__device__ __forceinline__ void xcd_barrier(const XcdBarrier& b) {
    asm volatile("s_waitcnt vmcnt(0)" ::: "memory");
    __syncthreads();
    if (b.wv == 0u && lane_id_() == 0) {
        unsigned* bar = b.bar;
        __builtin_amdgcn_s_waitcnt(0);
        unsigned nloc = b.st[0], nx = b.st[1];
        if (nloc == 0u) { xcd_barrier_complete(bar, b.x, nloc, nx); b.st[0] = nloc; b.st[1] = nx; }
        const unsigned old = xb_add(&bar[XB_XSUB(b.x)], 1u);
        const unsigned gen = old / nloc;
        if (old + 1u == (gen + 1u) * nloc) {
            __builtin_amdgcn_fence(__ATOMIC_RELEASE, "agent");
            asm volatile("s_waitcnt vmcnt(0)" ::: "memory");
            const unsigned og = xb_add(&bar[XB_TOP], 1u);
            const unsigned tg = og / nx;
            if (og + 1u == (tg + 1u) * nx) xb_add(&bar[XB_TOPGEN], 1u);
            else XB_SPIN(xb_ld(&bar[XB_TOPGEN]) == tg, bar);
            __builtin_amdgcn_fence(__ATOMIC_ACQUIRE, "agent");
            xb_add(&bar[XB_XGEN(b.x)], 1u);
            asm volatile("s_waitcnt vmcnt(0)" ::: "memory");
        } else {
            XB_SPIN(xb_ld(&bar[XB_XGEN(b.x)]) == gen, bar);
            __builtin_amdgcn_fence(__ATOMIC_ACQUIRE, "agent");
            asm volatile("s_waitcnt vmcnt(0)" ::: "memory");
        }
    }
    __syncthreads();
}


constexpr int NPHASE = 21;

__device__ __forceinline__ void run_phase(const Ctx c, const PV& p, int ph, char* shm) {
  const int l = (ph == 0) ? 0 : (ph - 1) / 10, s = (ph == 0) ? -1 : (ph - 1) % 10;
  if (s == 0 || s == 2 || s == 5 || s == 7 || s == 8) {
    GemmDesc gd{};
    gd.eproj = EpiProj{(u16*)(p.ws() + OFF_P), (float*)(p.ws() + OFF_DTRAW)};
    gd.elora = EpiLora{(u16*)(p.ws() + OFF_E), (u16*)(p.ws() + OFF_A), (u16*)(p.ws() + OFF_G), p.in(IW0) + (size_t)l * 1024, p.in(IA0) + (size_t)l * 1024};
    gd.eresh = EpiResidB{(u16*)(p.ws() + OFF_PRE), (const u16*)p.out()};
    gd.eresb = EpiResidB{(u16*)(p.ws() + OFF_PRE), (const u16*)(p.ws() + OFF_H)};
    gd.erelu = EpiRelu2{(u16*)(p.ws() + OFF_ACT)};
    if (s == 0)      { gd.A = (const u16*)(p.ws() + OFF_H);    gd.Bt = (const u16*)(p.ws() + OFF_WIN);   gd.N = NPROJ; gd.K = DM;  gd.kind = 0; }
    else if (s == 2) { gd.A = (const u16*)(p.ws() + OFF_S);    gd.Bt = (const u16*)(p.ws() + OFF_WLORA); gd.N = 2560;  gd.K = 256; gd.kind = 1; }
    else if (s == 5) { gd.A = (const u16*)(p.ws() + OFF_YMIX); gd.Bt = (const u16*)(p.ws() + OFF_WOUT);  gd.N = DM;    gd.K = DM;  gd.kind = 2; }
    else if (s == 7) { gd.A = (const u16*)(p.ws() + OFF_H);    gd.Bt = (const u16*)(p.ws() + OFF_WFC);   gd.N = DFF;   gd.K = DM;  gd.kind = 3; }
    else             { gd.A = (const u16*)(p.ws() + OFF_ACT);  gd.Bt = (const u16*)(p.ws() + OFF_WPROJ); gd.N = DM;    gd.K = DFF; gd.kind = 4; }
    gemm_phase(c, gd, shm);
    return;
  }
  switch (s) {
    case -1:
#if PROBE_CLK
      if (c.tid < 256) {
        float a = (float)c.tid, b = 1.0000001f, cc = 1e-9f;
        for (int it = 0; it < 32768; ++it) { a = rowsum4(a) * b + cc; }
        if (a == 12345.678f) p.out()[0] = a;
      }
#endif
      ln_phase(c, p.in(IX), p.in(ILN0G), p.in(ILN0B), p.out(), (u16*)(p.ws() + OFF_H));
      convert_weights(c, p, 0, shm);
      break;
    case 1: prep_phase(c, p, l); break;
    case 3: mixer_phase(c, p, l, shm); break;
    case 4: post_phase(c, p, l); break;
    case 6: ln_phase_b(c, (const u16*)(p.ws() + OFF_PRE), p.in(ILN1G) + (size_t)l * DM, p.in(ILN1B) + (size_t)l * DM, p.out(), (u16*)(p.ws() + OFF_H), false, true, false); break;
    case 9:
      ln_phase_b(c, (const u16*)(p.ws() + OFF_PRE), p.in(ILN2G) + (size_t)l * DM, p.in(ILN2B) + (size_t)l * DM, p.out(), (u16*)(p.ws() + OFF_H), l != 0, l == 0, l == 0);
      if (l == 0) convert_weights(c, p, 1, shm);
      break;
    default: break;
  }
}

__global__ void __launch_bounds__(512) mega(Params p, int lo, int hi) {
  extern __shared__ __attribute__((aligned(16))) char shm[];
  volatile LAS unsigned* xst = (volatile LAS unsigned*)(shm + XB_LDS_OFF);
  if (threadIdx.x == 0) { xst[0] = 0u; xst[1] = 0u; xst[2] = 0u; xst[3] = 0u; }
  __syncthreads();
  XcdBarrier xb = xcd_barrier_post((unsigned*)(p.ws + OFF_BAR), xst);
  if (hi > 1000) cg::this_grid().sync();
#if PROBE_SYNC
  if (hi - lo > 1) { for (int i = 0; i < 20; ++i) xcd_barrier(xb); }
#endif
  for (int ph = lo; ph < hi; ++ph) {
    int reps = 1;
#if PROBE_REP
    if (ph > 0 && ((PROBE_REP >> ((ph - 1) % 10)) & 1)) reps = 2;
#endif
    for (int rep = 0; rep < reps; ++rep) {
      long z; int zi;
      asm volatile("s_mov_b64 %0, 0\n\ts_mov_b32 %1, 0" : "=s"(z), "=s"(zi));
      const PV q{p, z};
      int tidv = (int)xb.wv * 64 + lane_id_(); asm volatile("" : "+v"(tidv));
      Ctx c{tidv, (int)blockIdx.x + zi, (int)gridDim.x + zi};
      run_phase(c, q, ph, shm);
      if (rep + 1 < reps || ph + 1 < hi) { xcd_barrier(xb); }
    }
  }
}

extern "C" void kernel_launch(void* const* d_in, const int* in_sizes, int n_in, void* d_out, int out_size,
                              void* d_ws, size_t ws_size, hipStream_t stream) {
  if (ws_size < WS_NEED) { fprintf(stderr, "workspace too small: %zu < %zu\n", ws_size, WS_NEED); return; }
  Params p{};
  for (int i = 0; i < NIN; ++i) p.in[i] = (const float*)d_in[i];
  p.out = (float*)d_out;
  p.ws = (char*)d_ws;
  hipFuncSetAttribute((const void*)mega, hipFuncAttributeMaxDynamicSharedMemorySize, SHM_BYTES);
#if COOP
  hipMemsetAsync((char*)d_ws + OFF_BAR, 0, XCD_BAR_WORDS * sizeof(unsigned), stream);
  int lo = 0, hi = NPHASE;
  void* args[] = {&p, &lo, &hi};
  hipError_t e = hipLaunchCooperativeKernel((const void*)mega, dim3(256), dim3(512), args, SHM_BYTES, stream);
  if (e != hipSuccess) fprintf(stderr, "cooperative launch failed: %s\n", hipGetErrorString(e));
#else
  for (int ph = 0; ph < NPHASE; ++ph) mega<<<dim3(256), dim3(512), SHM_BYTES, stream>>>(p, ph, ph + 1);
#endif
}
```

```cpp
#include <hip/hip_runtime.h>
#include <hip/hip_bf16.h>
#include <hip/hip_cooperative_groups.h>
#include <cstdio>
namespace cg = cooperative_groups;

#ifndef COOP
#define COOP 1
#endif
#define PROBE_MIX 0
#define PROBE_CLK 0
#define PROBE_SYNC 0
#define GEMM_REGSTAGE 0
#define PROBE_REP 0x000

typedef unsigned short u16;
typedef unsigned int u32;
using bf16x8 = __attribute__((ext_vector_type(8))) short;
using f32x4 = __attribute__((ext_vector_type(4))) float;
using f32x16 = __attribute__((ext_vector_type(16))) float;
using i32x4 = __attribute__((ext_vector_type(4))) int;

constexpr int MTOK = 32768, SEQ = 2048, DM = 1024, DFF = 4096;
constexpr int NPROJ = 3584;
constexpr int SSD_COLS = 1552;
constexpr float ALPHA = 1.4142135623730951f;
constexpr float LN_EPS = 1e-5f, RMS_EPS = 1e-5f, GN_EPS = 64e-5f;

enum { IX=0, ILN0G, ILN0B, IWIN, ICONVW, ICONVB, IDTB, IALOG, IDSKIP, ISSDG, IMU, IW0, IWUP, IA0, IAUP, IGUP,
       IKK, IKA, IRK, ILNXG, ILNXB, IWOUT, ILN1G, ILN1B, IWFC, IWPROJ, ILN2G, ILN2B, NIN };

constexpr size_t OFF_WIN = 0;
constexpr size_t OFF_WOUT = 7340032;
constexpr size_t OFF_WFC = 9437184;
constexpr size_t OFF_WPROJ = 17825792;
constexpr size_t OFF_WLORA = 26214400;
constexpr size_t OFF_H = 27525120;
constexpr size_t OFF_XS = OFF_H;
constexpr size_t OFF_BM = OFF_H + 33554432;
constexpr size_t OFF_CM = OFF_H + 50331648;
constexpr size_t OFF_P = OFF_H + 67108864;
constexpr size_t OFF_E = OFF_P;
constexpr size_t OFF_A = OFF_P + 67108864;
constexpr size_t OFF_G = OFF_P + 134217728;
constexpr size_t OFF_YR = OFF_P + 167772160;
constexpr size_t OFF_YMIX = OFF_P;
constexpr size_t OFF_ACT = OFF_P;
constexpr size_t OFF_S = OFF_P + 234881024;
constexpr size_t OFF_Q = OFF_S + 67108864;
constexpr size_t OFF_R = OFF_Q;
constexpr size_t OFF_K = OFF_Q + 33554432;
constexpr size_t OFF_V = OFF_Q + 67108864;
constexpr size_t OFF_SZ = OFF_Q + 100663296;
constexpr size_t OFF_PRE = OFF_Q;
constexpr size_t OFF_SM = OFF_Q + 134217728;
constexpr size_t OFF_DT = OFF_SM;
constexpr size_t OFF_INVN = OFF_SM + 2097152;
constexpr size_t OFF_DTRAW = OFF_S + 50331648;
constexpr size_t OFF_BAR = OFF_SM + 4194304;
constexpr size_t WS_NEED = OFF_BAR + 16384;

struct Params {
  const float* in[NIN];
  float* out;
  char* ws;
};
struct Ctx { int tid, bid, nb; };
__device__ __forceinline__ int lane_id_() { int l; asm volatile("v_mbcnt_lo_u32_b32 %0, -1, 0\n\tv_mbcnt_hi_u32_b32 %0, -1, %0" : "=v"(l)); return l; }
struct PV {
  const Params& pr; long z;
  __device__ __forceinline__ const float* in(int i) const { return pr.in[i] + z; }
  __device__ __forceinline__ char* ws() const { return pr.ws + z; }
  __device__ __forceinline__ float* out() const { return pr.out + z; }
};

typedef __bf16 hwbf16x2 __attribute__((ext_vector_type(2)));
typedef float hwf32x2 __attribute__((ext_vector_type(2)));
__device__ __forceinline__ u16 f2bf(float f) { __bf16 r = (__bf16)f; return __builtin_bit_cast(u16, r); }
__device__ __forceinline__ float bf2f(u16 h) { return __uint_as_float(((u32)h) << 16); }
__device__ __forceinline__ float bflo(u32 w) { return __uint_as_float(w << 16); }
__device__ __forceinline__ float bfhi(u32 w) { return __uint_as_float(w & 0xffff0000u); }
__device__ __forceinline__ u32 pack2(float a, float b) { hwf32x2 v{a, b}; hwbf16x2 r = __builtin_convertvector(v, hwbf16x2); return __builtin_bit_cast(u32, r); }
__device__ __forceinline__ float sigmoidf_(float x) { return __builtin_amdgcn_rcpf(1.f + __expf(-x)); }
__device__ __forceinline__ float siluf_(float x) { return x * __builtin_amdgcn_rcpf(1.f + __expf(-x)); }
__device__ __forceinline__ float tanhf_(float x) { return 1.f - 2.f * __builtin_amdgcn_rcpf(1.f + __expf(2.f * x)); }
__device__ __forceinline__ float softplusf_(float x) { return fmaxf(x, 0.f) + log1pf(__expf(-fabsf(x))); }
__device__ __forceinline__ uint4 ldnt16(const void* p) {
  i32x4 v = __builtin_nontemporal_load((const i32x4*)p);
  return make_uint4((u32)v[0], (u32)v[1], (u32)v[2], (u32)v[3]);
}
__device__ __forceinline__ float4 ldnt16f(const void* p) {
  uint4 v = ldnt16(p);
  return make_float4(__uint_as_float(v.x), __uint_as_float(v.y), __uint_as_float(v.z), __uint_as_float(v.w));
}
__device__ __forceinline__ float wave_sum(float v) {
#pragma unroll
  for (int o = 32; o >= 1; o >>= 1) v += __shfl_xor(v, o);
  return v;
}

__device__ __forceinline__ uint4 pack8v(f32x4 a, f32x4 b) {
  uint4 o; o.x = pack2(a[0], a[1]); o.y = pack2(a[2], a[3]); o.z = pack2(b[0], b[1]); o.w = pack2(b[2], b[3]);
  return o;
}
struct EpiProj {
  u16* proj; float* dt;
  __device__ __forceinline__ void operator()(int row, int col, f32x4 v, f32x4 w) const {
    *(uint4*)(proj + (size_t)row * NPROJ + col) = pack8v(v, w);
    if (col >= 1536 && col < 1552) { f32x4* d = (f32x4*)(dt + (size_t)row * 16 + (col - 1536)); d[0] = v; d[1] = w; }
  }
};
struct EpiLora {
  u16* e; u16* a; u16* g; const float* w0; const float* a0;
  __device__ __forceinline__ void operator()(int row, int col, f32x4 v, f32x4 w) const {
    if (col < 1024) {
      int d = col >> 9, c = col & 511;
      f32x4 b0 = *(const f32x4*)(w0 + col), b1 = *(const f32x4*)(w0 + col + 4);
      f32x4 o0, o1;
#pragma unroll
      for (int j = 0; j < 4; ++j) { o0[j] = 0.6065306597126334f * sigmoidf_(b0[j] + v[j]); o1[j] = 0.6065306597126334f * sigmoidf_(b1[j] + w[j]); }
      *(uint4*)(e + ((size_t)d * MTOK + row) * 512 + c) = pack8v(o0, o1);
    } else if (col < 2048) {
      int cc = col - 1024, d = cc >> 9, c = cc & 511;
      f32x4 b0 = *(const f32x4*)(a0 + cc), b1 = *(const f32x4*)(a0 + cc + 4);
      f32x4 o0, o1;
#pragma unroll
      for (int j = 0; j < 4; ++j) { o0[j] = sigmoidf_(b0[j] + v[j]); o1[j] = sigmoidf_(b1[j] + w[j]); }
      *(uint4*)(a + ((size_t)d * MTOK + row) * 512 + c) = pack8v(o0, o1);
    } else {
      *(uint4*)(g + (size_t)row * 512 + (col - 2048)) = pack8v(v, w);
    }
  }
};
struct EpiResid {
  u16* pre; const float* h;
  __device__ __forceinline__ void operator()(int row, int col, f32x4 v, f32x4 w) const {
    size_t o = (size_t)row * DM + col;
    f32x4 h0 = *(const f32x4*)(h + o), h1 = *(const f32x4*)(h + o + 4);
    *(uint4*)(pre + o) = pack8v(h0 * ALPHA + v, h1 * ALPHA + w);
  }
};
struct EpiResidB {
  u16* pre; const u16* hb;
  __device__ __forceinline__ void operator()(int row, int col, f32x4 v, f32x4 w) const {
    size_t o = (size_t)row * DM + col;
    uint4 hv = ldnt16(hb + o);
    f32x4 h0 = f32x4{bflo(hv.x), bfhi(hv.x), bflo(hv.y), bfhi(hv.y)}, h1 = f32x4{bflo(hv.z), bfhi(hv.z), bflo(hv.w), bfhi(hv.w)};
    *(uint4*)(pre + o) = pack8v(h0 * ALPHA + v, h1 * ALPHA + w);
  }
};
struct EpiRelu2 {
  u16* act;
  __device__ __forceinline__ void operator()(int row, int col, f32x4 v, f32x4 w) const {
    f32x4 r0, r1;
#pragma unroll
    for (int j = 0; j < 4; ++j) { float a = fmaxf(v[j], 0.f), b = fmaxf(w[j], 0.f); r0[j] = a * a; r1[j] = b * b; }
    *(uint4*)(act + (size_t)row * DFF + col) = pack8v(r0, r1);
  }
};

constexpr int BM = 256, BN = 256, BK = 64, NXCD = 8, WGM = 8;
constexpr int SHM_BYTES = 147520;

__device__ __forceinline__ int lds_byte(int r, int c) {
  int st = (r >> 4) * 2 + (c >> 5), rr = r & 15, cc = c & 31, ob = rr * 64 + cc * 2;
  return st * 1024 + (ob ^ (((ob >> 9) & 1) << 5));
}
__device__ __forceinline__ void stage_rc(int b, int& R, int& C) {
  int st = b / 1024, sb = b % 1024, swz = sb ^ (((sb >> 9) & 1) << 5);
  R = (st >> 1) * 16 + swz / 64; C = (st & 1) * 32 + (swz % 64) / 2;
}

struct GemmDesc {
  const u16* A; const u16* Bt; int N, K, kind;
  EpiProj eproj; EpiLora elora; EpiResidB eresh; EpiResidB eresb; EpiRelu2 erelu;
};

__device__ __forceinline__ void gemm_phase(const Ctx c, const GemmDesc& gd, char* shm) {
  const u16* __restrict__ A = gd.A; const u16* __restrict__ Bt = gd.Bt;
  const int M = MTOK, N = gd.N, K = gd.K;
  constexpr int TILE_A = BM * BK * 2, TILE_B = BN * BK * 2, GLA = TILE_A / 8192, GLB = TILE_B / 8192, STAGE_B = TILE_A + TILE_B;
#define SA(b) (shm + (b) * STAGE_B)
#define SB(b) (shm + (b) * STAGE_B + TILE_A)
#define WAIT_V(n) asm volatile("s_waitcnt vmcnt(%0)" ::"n"(n) : "memory")
#define SCHED() __builtin_amdgcn_sched_barrier(0)
#define RAW_BARRIER() do { asm volatile("s_waitcnt lgkmcnt(0)" ::: "memory"); __builtin_amdgcn_s_barrier(); } while (0)
  const int nM = M / BM, nN = N / BN, nwg = nM * nN;
  const int tid = c.tid, wid = tid >> 6, lane = tid & 63, wr = wid >> 2, wc = wid & 3, fr = lane & 15, fq = lane >> 4;
  const int nt = K / BK;
  int sR[GLA], sC[GLA];
#pragma unroll
  for (int i = 0; i < GLA; ++i) stage_rc(wid * 1024 + i * 8192 + lane * 16, sR[i], sC[i]);
#define GLDS_STAGE(buf, kt, AP, BP) do { int Kl = K; asm volatile("" : "+s"(Kl)); \
    _Pragma("unroll") for (int i = 0; i < GLA; ++i) \
      __builtin_amdgcn_global_load_lds((const u32*)((AP) + (kt) * BK + (long)i * 64 * Kl), (u32*)(SA(buf) + wid * 1024 + i * 8192), 16, 0, 0); \
    _Pragma("unroll") for (int i = 0; i < GLB; ++i) \
      __builtin_amdgcn_global_load_lds((const u32*)((BP) + (kt) * BK + (long)i * 64 * Kl), (u32*)(SB(buf) + wid * 1024 + i * 8192), 16, 0, 0); } while (0)
#define KHALF(buf, ks, mh) do { bf16x8 At[4]; \
    _Pragma("unroll") for (int m = 0; m < 4; ++m) At[m] = *(const bf16x8*)(SA(buf) + lds_byte(wr * 128 + (mh) * 64 + m * 16 + fr, (ks) * 32 + fq * 8)); \
    _Pragma("unroll") for (int m = 0; m < 4; ++m) _Pragma("unroll") for (int n = 0; n < 4; ++n) \
      acc[(mh) * 4 + m][n] = __builtin_amdgcn_mfma_f32_16x16x32_bf16(Bf[n], At[m], acc[(mh) * 4 + m][n], 0, 0, 0); } while (0)
#define KSTEP(buf, ks) do { bf16x8 Bf[4]; \
    _Pragma("unroll") for (int n = 0; n < 4; ++n) Bf[n] = *(const bf16x8*)(SB(buf) + lds_byte(wc * 64 + n * 16 + fr, (ks) * 32 + fq * 8)); \
    KHALF(buf, ks, 0); KHALF(buf, ks, 1); } while (0)
#define COMPUTE(buf) do { KSTEP(buf, 0); KSTEP(buf, 1); } while (0)

  const int sRb = (sR[0] & ~31) + 8 * ((sR[0] & 15) >> 2) + (sR[0] & 3) + ((sR[0] & 16) ? 4 : 0);
#define TILE_COORDS(wg_, brow_, bcol_) do { int wgid = (wg_); \
    { int q = nwg / NXCD, r = nwg % NXCD, xcd = wgid % NXCD, off = wgid / NXCD; \
      wgid = (xcd < r ? xcd * (q + 1) : r * (q + 1) + (xcd - r) * q) + off; } \
    int nig = WGM * nN, gid = wgid / nig, fm = gid * WGM, gsz = min(nM - fm, WGM); \
    int pm = fm + ((wgid % nig) % gsz), pn = (wgid % nig) / gsz; brow_ = pm * BM; bcol_ = pn * BN; } while (0)
  int wg0 = c.bid;
  bool have = wg0 < nwg;
  int brow = 0, bcol = 0;
  const u16* ap = A; const u16* bp = Bt;
  if (have) {
    TILE_COORDS(wg0, brow, bcol);
    ap = A + (long)brow * K + (long)sR[0] * K + sC[0];
    bp = Bt + (long)bcol * K + (long)sRb * K + sC[0];
    GLDS_STAGE(0, 0, ap, bp);
  }
  while (have) {
    f32x4 acc[8][4];
#pragma unroll
    for (int m = 0; m < 8; ++m)
#pragma unroll
      for (int n = 0; n < 4; ++n) acc[m][n] = f32x4{0.f, 0.f, 0.f, 0.f};
    const int wgn = wg0 + c.nb;
    const bool hn = wgn < nwg;
    int brn = 0, bcn = 0;
    const u16* apn = A; const u16* bpn = Bt;
    if (hn) {
      TILE_COORDS(wgn, brn, bcn);
      apn = A + (long)brn * K + (long)sR[0] * K + sC[0];
      bpn = Bt + (long)bcn * K + (long)sRb * K + sC[0];
    }
    WAIT_V(0); __syncthreads();
#pragma unroll 2
    for (int t = 0; t < nt; ++t) {
      int cur = t & 1;
      if (t + 1 < nt) GLDS_STAGE(cur ^ 1, t + 1, ap, bp);
      else if (hn) GLDS_STAGE(0, 0, apn, bpn);
      COMPUTE(cur);
      if (t + 1 < nt) { WAIT_V(0); __syncthreads(); }
    }
#define EPILOOP(EPI) \
    _Pragma("unroll") for (int m = 0; m < 8; ++m) \
    _Pragma("unroll") for (int n = 0; n < 4; n += 2) \
      EPI(brow + wr * 128 + m * 16 + fr, bcol + wc * 64 + n * 16 + fq * 8, acc[m][n], acc[m][n + 1]);
    if (gd.kind == 0) { EPILOOP(gd.eproj) }
    else if (gd.kind == 1) { EPILOOP(gd.elora) }
    else if (gd.kind == 2) { EPILOOP(gd.eresh) }
    else if (gd.kind == 4) { EPILOOP(gd.eresb) }
    else { EPILOOP(gd.erelu) }
#undef EPILOOP
    wg0 = wgn; have = hn; brow = brn; bcol = bcn; ap = apn; bp = bpn;
  }
#undef TILE_COORDS
#undef SA
#undef SB
#undef GLDS_STAGE
#undef KHALF
#undef KSTEP
#undef COMPUTE
}

__device__ void transpose_convert(const Ctx c, const float* __restrict__ src, u16* __restrict__ dst, int K, int N, int Npad, float* lds) {
  const int tid = c.tid;
  const int tk = K / 64, tn = Npad / 64, ntile = tk * tn;
  for (int t = c.bid; t < ntile; t += c.nb) {
    int k0 = (t % tk) * 64, n0 = (t / tk) * 64;
    __syncthreads();
#pragma unroll
    for (int i = 0; i < 8; ++i) {
      int kk = i * 8 + (tid >> 6), nn = tid & 63;
      float v = (n0 + nn < N) ? __builtin_nontemporal_load(src + (size_t)(k0 + kk) * N + n0 + nn) : 0.f;
      lds[kk * 65 + nn] = v;
    }
    __syncthreads();
#pragma unroll
    for (int i = 0; i < 8; ++i) {
      int nn = i * 8 + (tid >> 6), kk = tid & 63;
      dst[(size_t)(n0 + nn) * K + k0 + kk] = f2bf(lds[kk * 65 + nn]);
    }
  }
}

__device__ void convert_weights(const Ctx c, const PV& p, int l, char* shm) {
  float* lds = (float*)shm;
  transpose_convert(c, p.in(IWIN) + (size_t)l * 1024 * 3344, (u16*)(p.ws() + OFF_WIN), 1024, 3344, NPROJ, lds);
  transpose_convert(c, p.in(IWOUT) + (size_t)l * 1024 * 1024, (u16*)(p.ws() + OFF_WOUT), 1024, 1024, 1024, lds);
  transpose_convert(c, p.in(IWFC) + (size_t)l * 1024 * 4096, (u16*)(p.ws() + OFF_WFC), 1024, 4096, 4096, lds);
  transpose_convert(c, p.in(IWPROJ) + (size_t)l * 4096 * 1024, (u16*)(p.ws() + OFF_WPROJ), 4096, 1024, 1024, lds);
  u16* wl = (u16*)(p.ws() + OFF_WLORA);
  const float* wup = p.in(IWUP) + (size_t)l * 2 * 64 * 512;
  const float* aup = p.in(IAUP) + (size_t)l * 2 * 64 * 512;
  const float* gup = p.in(IGUP) + (size_t)l * 128 * 512;
  for (int idx = c.bid * 512 + c.tid; idx < 2560 * 256; idx += c.nb * 512) {
    int n = idx >> 8, k = idx & 255;
    float v = 0.f;
    if (n < 1024) { if (k < 64) { int d = n >> 9, c = n & 511; v = wup[((size_t)d * 64 + k) * 512 + c]; } }
    else if (n < 2048) { if (k >= 64 && k < 128) { int d = (n - 1024) >> 9, c = n & 511; v = aup[((size_t)d * 64 + (k - 64)) * 512 + c]; } }
    else { if (k >= 128) { int c = n - 2048; v = gup[(size_t)(k - 128) * 512 + c]; } }
    wl[idx] = f2bf(v);
  }
}

__device__ void ln_phase(const Ctx c, const float* __restrict__ src, const float* __restrict__ g, const float* __restrict__ b,
                         float* __restrict__ dstf, u16* __restrict__ dstb) {
  const int wave = c.tid >> 6, lane = c.tid & 63;
  float4 gg[4], bb[4];
#pragma unroll
  for (int i = 0; i < 4; ++i) { gg[i] = ((const float4*)g)[lane + 64 * i]; bb[i] = ((const float4*)b)[lane + 64 * i]; }
  int row = c.bid * 8 + wave;
  float4 v[4], nv[4];
  if (row < MTOK) {
#pragma unroll
    for (int i = 0; i < 4; ++i) v[i] = ldnt16f((const float4*)(src + (size_t)row * DM) + lane + 64 * i);
  }
  for (; row < MTOK; row += c.nb * 8) {
    const int nrow = row + c.nb * 8;
    if (nrow < MTOK) {
#pragma unroll
      for (int i = 0; i < 4; ++i) nv[i] = ldnt16f((const float4*)(src + (size_t)nrow * DM) + lane + 64 * i);
    }
    float sum = 0.f;
#pragma unroll
    for (int i = 0; i < 4; ++i) sum += v[i].x + v[i].y + v[i].z + v[i].w;
    float mean = wave_sum(sum) * (1.f / DM);
    float sq = 0.f;
#pragma unroll
    for (int i = 0; i < 4; ++i) {
      float a = v[i].x - mean, b2 = v[i].y - mean, c2 = v[i].z - mean, d = v[i].w - mean;
      sq += a * a + b2 * b2 + c2 * c2 + d * d;
    }
    float rstd = rsqrtf(wave_sum(sq) * (1.f / DM) + LN_EPS);
#pragma unroll
    for (int i = 0; i < 4; ++i) {
      float4 o;
      o.x = (v[i].x - mean) * rstd * gg[i].x + bb[i].x; o.y = (v[i].y - mean) * rstd * gg[i].y + bb[i].y;
      o.z = (v[i].z - mean) * rstd * gg[i].z + bb[i].z; o.w = (v[i].w - mean) * rstd * gg[i].w + bb[i].w;
      uint2 pk; pk.x = pack2(o.x, o.y); pk.y = pack2(o.z, o.w);
      ((uint2*)((u16*)dstf + (size_t)row * DM))[lane + 64 * i] = pk;
      ((uint2*)(dstb + (size_t)row * DM))[lane + 64 * i] = pk;
    }
#pragma unroll
    for (int i = 0; i < 4; ++i) v[i] = nv[i];
  }
}

__device__ __forceinline__ void unpack8(const uint4& v, float (&f)[8]) {
  f[0] = bflo(v.x); f[1] = bfhi(v.x); f[2] = bflo(v.y); f[3] = bfhi(v.y);
  f[4] = bflo(v.z); f[5] = bfhi(v.z); f[6] = bflo(v.w); f[7] = bfhi(v.w);
}
__device__ __forceinline__ uint4 pack8(const float (&f)[8]) {
  uint4 o; o.x = pack2(f[0], f[1]); o.y = pack2(f[2], f[3]); o.z = pack2(f[4], f[5]); o.w = pack2(f[6], f[7]);
  return o;
}

constexpr int LNG = 4;
__device__ void ln_phase_b(const Ctx c, const u16* __restrict__ src, const float* __restrict__ g, const float* __restrict__ b,
                           float* __restrict__ dstf, u16* __restrict__ dstb, bool write_f, bool write_b, bool write_h) {
  const int wave = c.tid >> 6, lane = c.tid & 63;
  float gg[16], bb[16];
#pragma unroll
  for (int i = 0; i < 2; ++i)
#pragma unroll
    for (int e = 0; e < 8; ++e) { gg[8 * i + e] = g[8 * (lane + 64 * i) + e]; bb[8 * i + e] = b[8 * (lane + 64 * i) + e]; }
  const int stride = c.nb * 8;
  int row0 = c.bid * 8 + wave;
  uint4 v[LNG][2], nv[LNG][2];
#define LN_LOAD(D, r0) do { _Pragma("unroll") for (int q = 0; q < LNG; ++q) { const int rr_ = (r0) + q * stride; \
      if (rr_ < MTOK) { D[q][0] = ldnt16((const uint4*)(src + (size_t)rr_ * DM) + lane); D[q][1] = ldnt16((const uint4*)(src + (size_t)rr_ * DM) + lane + 64); } } } while (0)
  LN_LOAD(v, row0);
  for (; row0 < MTOK; row0 += LNG * stride) {
    const int nrow0 = row0 + LNG * stride;
    if (nrow0 < MTOK) LN_LOAD(nv, nrow0);
#pragma unroll
    for (int q = 0; q < LNG; ++q) {
      const int row = row0 + q * stride;
      if (row < MTOK) {
        float x[16];
        { float t0[8], t1[8]; unpack8(v[q][0], t0); unpack8(v[q][1], t1);
#pragma unroll
          for (int e = 0; e < 8; ++e) { x[e] = t0[e]; x[8 + e] = t1[e]; } }
        float sum = 0.f;
#pragma unroll
        for (int e = 0; e < 16; ++e) sum += x[e];
        const float mean = wave_sum(sum) * (1.f / DM);
        float sq = 0.f;
#pragma unroll
        for (int e = 0; e < 16; ++e) { float dlt = x[e] - mean; sq += dlt * dlt; }
        const float rstd = rsqrtf(wave_sum(sq) * (1.f / DM) + LN_EPS);
#pragma unroll
        for (int i = 0; i < 2; ++i) {
          float o[8];
#pragma unroll
          for (int e = 0; e < 8; ++e) o[e] = (x[8 * i + e] - mean) * rstd * gg[8 * i + e] + bb[8 * i + e];
          if (write_f) {
            float4* d = (float4*)(dstf + (size_t)row * DM + 8 * (lane + 64 * i));
            d[0] = make_float4(o[0], o[1], o[2], o[3]); d[1] = make_float4(o[4], o[5], o[6], o[7]);
          }
          if (write_b) ((uint4*)(dstb + (size_t)row * DM))[lane + 64 * i] = pack8(o);
          if (write_h) ((uint4*)((u16*)dstf + (size_t)row * DM))[lane + 64 * i] = pack8(o);
        }
      }
    }
#pragma unroll
    for (int q = 0; q < LNG; ++q) { v[q][0] = nv[q][0]; v[q][1] = nv[q][1]; }
  }
#undef LN_LOAD
}

constexpr int PT = 32, PB = 4;
__device__ __forceinline__ void prep_conv(const PV& p, int l, int tile, int cg) {
  const u16* proj = (const u16*)(p.ws() + OFF_P);
  const uint4 zero4 = make_uint4(0u, 0u, 0u, 0u);
  const int t0 = tile * PT, ts0 = t0 & (SEQ - 1);
  {
      const int c0 = cg * 8;
      const float* cw = p.in(ICONVW) + (size_t)l * 5 * 1024 + c0;
      const float* cb = p.in(ICONVB) + (size_t)l * 1024 + c0;
      float w[5][8], bias[8];
#pragma unroll
      for (int j = 0; j < 5; ++j)
#pragma unroll
        for (int e = 0; e < 8; ++e) w[j][e] = cw[j * 1024 + e];
#pragma unroll
      for (int e = 0; e < 8; ++e) bias[e] = cb[e];
      u16* dst; int dstride;
      if (c0 < 512) { dst = (u16*)(p.ws() + OFF_XS) + c0; dstride = 512; }
      else if (c0 < 768) { dst = (u16*)(p.ws() + OFF_BM) + (c0 - 512); dstride = 256; }
      else { dst = (u16*)(p.ws() + OFF_CM) + (c0 - 768); dstride = 256; }
      const u16* src = proj + (size_t)t0 * NPROJ + 512 + c0;
      uint4 x0, x1, x2, x3;
      x0 = (ts0 >= 2) ? ldnt16(src - 2 * (long)NPROJ) : zero4;
      x1 = (ts0 >= 1) ? ldnt16(src - (long)NPROJ) : zero4;
      x2 = ldnt16(src);
      x3 = ldnt16(src + NPROJ);
      uint4 cur[PB], nxt[PB];
#pragma unroll
      for (int u = 0; u < PB; ++u) cur[u] = (ts0 + u + 2 < SEQ) ? ldnt16(src + (long)(u + 2) * NPROJ) : zero4;
      for (int tb = 0; tb < PT; tb += PB) {
        if (tb + PB < PT) {
#pragma unroll
          for (int u = 0; u < PB; ++u) nxt[u] = (ts0 + tb + PB + u + 2 < SEQ) ? ldnt16(src + (long)(tb + PB + u + 2) * NPROJ) : zero4;
        }
#pragma unroll
        for (int u = 0; u < PB; ++u) {
          const uint4 x4 = cur[u];
          float f0[8], f1[8], f2[8], f3[8], f4[8], o[8];
          unpack8(x0, f0); unpack8(x1, f1); unpack8(x2, f2); unpack8(x3, f3); unpack8(x4, f4);
#pragma unroll
          for (int e = 0; e < 8; ++e) {
            float a = bias[e] + w[0][e] * f0[e] + w[1][e] * f1[e] + w[2][e] * f2[e] + w[3][e] * f3[e] + w[4][e] * f4[e];
            o[e] = siluf_(a);
          }
          *(uint4*)(dst + (size_t)(t0 + tb + u) * dstride) = pack8(o);
          x0 = x1; x1 = x2; x2 = x3; x3 = x4;
        }
#pragma unroll
        for (int u = 0; u < PB; ++u) cur[u] = nxt[u];
      }
  }
}

__device__ __forceinline__ void prep_rw(const PV& p, int l, int tile, int rg) {
  const u16* proj = (const u16*)(p.ws() + OFF_P);
  const uint4 zero4 = make_uint4(0u, 0u, 0u, 0u);
  const int t0 = tile * PT, ts0 = t0 & (SEQ - 1);
  {
      const int c0 = rg * 8;
      const float* mup = p.in(IMU) + (size_t)l * 1792 + c0;
      float mu[8], kkc[8];
#pragma unroll
      for (int e = 0; e < 8; ++e) mu[e] = mup[e];
      const bool isk = (rg >= 64 && rg < 128);
      if (isk) {
#pragma unroll
        for (int e = 0; e < 8; ++e) kkc[e] = p.in(IKK)[(size_t)l * 512 + (c0 - 512) + e];
      } else {
#pragma unroll
        for (int e = 0; e < 8; ++e) kkc[e] = 0.f;
      }
      u16* dst; int dstride;
      if (rg < 64) { dst = (u16*)(p.ws() + OFF_R) + c0; dstride = 512; }
      else if (rg < 128) { dst = (u16*)(p.ws() + OFF_K) + (c0 - 512); dstride = 512; }
      else if (rg < 192) { dst = (u16*)(p.ws() + OFF_V) + (c0 - 1024); dstride = 512; }
      else { dst = (u16*)(p.ws() + OFF_S) + (c0 - 1536); dstride = 256; }
      float* invn = (float*)(p.ws() + OFF_INVN);
      const u16* src = proj + (size_t)t0 * NPROJ + SSD_COLS + c0;
      uint4 xm, x0;
      xm = (ts0 >= 1) ? ldnt16(src - (long)NPROJ) : zero4;
      x0 = ldnt16(src);
      uint4 cur[PB], nxt[PB];
#pragma unroll
      for (int u = 0; u < PB; ++u) cur[u] = (ts0 + u + 1 < SEQ) ? ldnt16(src + (long)(u + 1) * NPROJ) : zero4;
      for (int tb = 0; tb < PT; tb += PB) {
        if (tb + PB < PT) {
#pragma unroll
          for (int u = 0; u < PB; ++u) nxt[u] = (ts0 + tb + PB + u + 1 < SEQ) ? ldnt16(src + (long)(tb + PB + u + 1) * NPROJ) : zero4;
        }
#pragma unroll
        for (int u = 0; u < PB; ++u) {
          const uint4 xp = cur[u];
          const int t = tb + u;
          float fm[8], f0[8], fp[8], o[8];
          unpack8(xm, fm); unpack8(x0, f0); unpack8(xp, fp);
#pragma unroll
          for (int e = 0; e < 8; ++e) o[e] = f0[e] + (0.5f * (fm[e] + fp[e]) - f0[e]) * mu[e];
          if (rg >= 192) {
            if (rg < 200) {
#pragma unroll
              for (int e = 0; e < 8; ++e) o[e] = tanhf_(o[e]);
            } else if (rg >= 208) {
#pragma unroll
              for (int e = 0; e < 8; ++e) o[e] = sigmoidf_(o[e]);
            }
          }
          const uint4 ov = pack8(o);
          *(uint4*)(dst + (size_t)(t0 + t) * dstride) = ov;
          if (isk) {
            float kr[8]; unpack8(ov, kr);
            float ss = 0.f;
#pragma unroll
            for (int e = 0; e < 8; ++e) { float qv = kr[e] * kkc[e]; ss += qv * qv; }
            ss += __shfl_xor(ss, 1); ss += __shfl_xor(ss, 2); ss += __shfl_xor(ss, 4);
            if ((rg & 7) == 0) invn[(size_t)(t0 + t) * 8 + ((rg - 64) >> 3)] = 1.f / fmaxf(sqrtf(ss), 1e-12f);
          }
          xm = x0; x0 = xp;
        }
#pragma unroll
        for (int u = 0; u < PB; ++u) cur[u] = nxt[u];
      }
  }
}

__device__ __forceinline__ void prep_z(const PV& p, int l, int tile, int zg) {
  const u16* proj = (const u16*)(p.ws() + OFF_P);
  const uint4 zero4 = make_uint4(0u, 0u, 0u, 0u);
  const int t0 = tile * PT, ts0 = t0 & (SEQ - 1);
  {
      const int c0 = zg * 8;
      const u16* src = proj + (size_t)t0 * NPROJ + c0;
      u16* dst = (u16*)(p.ws() + OFF_SZ) + c0;
      for (int tb = 0; tb < PT; tb += PB) {
        uint4 xx[PB];
#pragma unroll
        for (int u = 0; u < PB; ++u) xx[u] = ldnt16(src + (long)(tb + u) * NPROJ);
#pragma unroll
        for (int u = 0; u < PB; ++u) {
          float f[8], o[8]; unpack8(xx[u], f);
#pragma unroll
          for (int e = 0; e < 8; ++e) o[e] = siluf_(f[e]);
          *(uint4*)(dst + (size_t)(t0 + tb + u) * 512) = pack8(o);
        }
      }
  }
}

__device__ void prep_phase(const Ctx c, const PV& p, int l) {
  const int tid = c.tid;
  constexpr int NT = MTOK / PT;
  for (int g = c.bid; g < NT / 4; g += c.nb) prep_conv(p, l, g * 4 + (tid >> 7), tid & 127);
  for (int g = c.bid; g < NT / 2; g += c.nb) { const int rg = tid & 255; if (rg < 224) prep_rw(p, l, g * 2 + (tid >> 8), rg); }
  for (int g = c.bid; g < NT / 8; g += c.nb) prep_z(p, l, g * 8 + (tid >> 6), tid & 63);
  {
    const float* dtraw = (const float*)(p.ws() + OFF_DTRAW);
    float* dt = (float*)(p.ws() + OFF_DT);
    float xv[4];
#pragma unroll
    for (int u = 0; u < 4; ++u) xv[u] = dtraw[(size_t)(u * c.nb + c.bid) * 512 + tid];
    const float bia = p.in(IDTB)[(size_t)l * 16 + (tid & 15)];
#pragma unroll
    for (int u = 0; u < 4; ++u) dt[(size_t)(u * c.nb + c.bid) * 512 + tid] = softplusf_(xv[u] + bia);
  }
}

__device__ __forceinline__ float rowsum4(float x) {
  auto r = __builtin_amdgcn_permlane16_swap(__float_as_uint(x), __float_as_uint(x), false, false);
  float y = __uint_as_float(r[0]) + __uint_as_float(r[1]);
  auto r2 = __builtin_amdgcn_permlane32_swap(__float_as_uint(y), __float_as_uint(y), false, false);
  return __uint_as_float(r2[0]) + __uint_as_float(r2[1]);
}

#define DPPB(I) " row_newbcast:" #I " row_mask:0xf bank_mask:0xf\n"

__device__ __forceinline__ float dot16(const float (&S)[16], float vec) {
  float acc;
  asm volatile("s_nop 1\n"
      "v_mul_f32_dpp %0, %17, %1" DPPB(0)
      "v_fmac_f32_dpp %0, %17, %2" DPPB(1)
      "v_fmac_f32_dpp %0, %17, %3" DPPB(2)
      "v_fmac_f32_dpp %0, %17, %4" DPPB(3)
      "v_fmac_f32_dpp %0, %17, %5" DPPB(4)
      "v_fmac_f32_dpp %0, %17, %6" DPPB(5)
      "v_fmac_f32_dpp %0, %17, %7" DPPB(6)
      "v_fmac_f32_dpp %0, %17, %8" DPPB(7)
      "v_fmac_f32_dpp %0, %17, %9" DPPB(8)
      "v_fmac_f32_dpp %0, %17, %10" DPPB(9)
      "v_fmac_f32_dpp %0, %17, %11" DPPB(10)
      "v_fmac_f32_dpp %0, %17, %12" DPPB(11)
      "v_fmac_f32_dpp %0, %17, %13" DPPB(12)
      "v_fmac_f32_dpp %0, %17, %14" DPPB(13)
      "v_fmac_f32_dpp %0, %17, %15" DPPB(14)
      "v_fmac_f32_dpp %0, %17, %16" DPPB(15)
      : "=&v"(acc)
      : "v"(S[0]), "v"(S[1]), "v"(S[2]), "v"(S[3]), "v"(S[4]), "v"(S[5]), "v"(S[6]), "v"(S[7]),
        "v"(S[8]), "v"(S[9]), "v"(S[10]), "v"(S[11]), "v"(S[12]), "v"(S[13]), "v"(S[14]), "v"(S[15]), "v"(vec));
  return acc;
}

#define UPD(I, SI) \
      "v_mul_f32_dpp " SI ", %16, " SI DPPB(I) \
      "v_fmac_f32_dpp " SI ", %17, %19" DPPB(I) \
      "v_fmac_f32_dpp " SI ", %18, %20" DPPB(I)
__device__ __forceinline__ void update16(float (&S)[16], float w, float b, float kd, float nskk, float vv) {
  asm volatile("s_nop 1\n"
      UPD(0, "%0") UPD(1, "%1") UPD(2, "%2") UPD(3, "%3") UPD(4, "%4") UPD(5, "%5") UPD(6, "%6") UPD(7, "%7")
      UPD(8, "%8") UPD(9, "%9") UPD(10, "%10") UPD(11, "%11") UPD(12, "%12") UPD(13, "%13") UPD(14, "%14") UPD(15, "%15")
      : "+v"(S[0]), "+v"(S[1]), "+v"(S[2]), "+v"(S[3]), "+v"(S[4]), "+v"(S[5]), "+v"(S[6]), "+v"(S[7]),
        "+v"(S[8]), "+v"(S[9]), "+v"(S[10]), "+v"(S[11]), "+v"(S[12]), "+v"(S[13]), "+v"(S[14]), "+v"(S[15])
      : "v"(w), "v"(b), "v"(kd), "v"(nskk), "v"(vv));
}

typedef float f32x2 __attribute__((ext_vector_type(2)));
constexpr int RB = 16;
constexpr int RW_STEP = 1536;
constexpr int RW_OFF = 90112;
constexpr int RW_CNT = RW_OFF + 2 * RB * RW_STEP;
constexpr int RW_YBUF = 139520;
constexpr int XB_LDS_OFF = 147456;

__device__ __forceinline__ void group_barrier(int* cnt, int& gen, int lane);

__device__ void rwkv_scan(const PV& p, int l, int item, int tid  , char* shm, int& gen) {
  const int d = item >> 7, b = (item >> 3) & 15, h = item & 7;
  const int j = tid >> 6, lane = tid & 63, vl = lane & 15, q = lane >> 4;
  const u16* rr = (const u16*)(p.ws() + OFF_R); const u16* kk_ = (const u16*)(p.ws() + OFF_K); const u16* vv_ = (const u16*)(p.ws() + OFF_V);
  const u16* ee = (const u16*)(p.ws() + OFF_E) + (size_t)d * MTOK * 512;
  const u16* aa = (const u16*)(p.ws() + OFF_A) + (size_t)d * MTOK * 512;
  const float* invn = (const float*)(p.ws() + OFF_INVN);
  u16* yr = (u16*)(p.ws() + OFF_YR) + (size_t)d * MTOK * 512;
  int* cnt = (int*)(shm + RW_CNT);
  const int ch = h * 64 + lane, chv = h * 64 + 16 * j + vl;
  const float kkc = p.in(IKK)[(size_t)l * 512 + ch];
  const float ka = p.in(IKA)[(size_t)l * 512 + ch];
  const long tok0 = (long)b * SEQ + (d ? SEQ - 1 : 0);
  const long dstep = d ? -1 : 1;

  u16 gr[4], gk[4], ge[4], ga[4], gv[4]; float gi[4];
#define RW_LOAD(n) do { _Pragma("unroll") for (int s = 0; s < 4; ++s) { \
      long tok = tok0 + dstep * ((n) * RB + 4 * j + s); \
      gr[s] = rr[tok * 512 + ch]; gk[s] = kk_[tok * 512 + ch]; ge[s] = __builtin_nontemporal_load(ee + tok * 512 + ch); ga[s] = __builtin_nontemporal_load(aa + tok * 512 + ch); \
      gv[s] = vv_[tok * 512 + ch]; gi[s] = invn[tok * 8 + h]; } } while (0)
#define RW_WRITE(n) do { _Pragma("unroll") for (int s = 0; s < 4; ++s) { \
      float* dst = (float*)(shm + RW_OFF + ((n) & 1) * RB * RW_STEP + (4 * j + s) * RW_STEP); \
      float r = bf2f(gr[s]), k = bf2f(gk[s]), e = bf2f(ge[s]), a = bf2f(ga[s]); \
      float kkv = k * kkc * gi[s]; \
      dst[lane] = kkv; dst[64 + lane] = __expf(-e); dst[128 + lane] = kkv * a; \
      dst[192 + lane] = k * (1.f + (a - 1.f) * ka); dst[256 + lane] = r; dst[320 + lane] = bf2f(gv[s]); } } while (0)

  const int q8 = lane >> 3, rp = lane & 7;
  float S0[8], S1[8];
#pragma unroll
  for (int i = 0; i < 8; ++i) { S0[i] = 0.f; S1[i] = 0.f; }
#define FMAC(acc, a, b) acc = __builtin_fmaf(a, b, acc)
#define FMUL(dst, a, b) dst = (a) * (b)
#define REDUCE2(x0, x1, t0, t1) do { \
    float _a = x0 + __builtin_bit_cast(float, __builtin_amdgcn_update_dpp(0, __builtin_bit_cast(int, x0), 0x128, 0xf, 0xf, false)); \
    float _b = x1 + __builtin_bit_cast(float, __builtin_amdgcn_update_dpp(0, __builtin_bit_cast(int, x1), 0x128, 0xf, 0xf, false)); \
    auto _r = __builtin_amdgcn_permlane16_swap(__float_as_uint(_a), __float_as_uint(_b), false, false); \
    float _c = __uint_as_float(_r[0]) + __uint_as_float(_r[1]); \
    auto _r2 = __builtin_amdgcn_permlane32_swap(__float_as_uint(_c), __float_as_uint(_c), false, false); \
    float _d = __uint_as_float(_r2[0]) + __uint_as_float(_r2[1]); \
    auto _r3 = __builtin_amdgcn_permlane16_swap(__float_as_uint(_d), __float_as_uint(_d), false, false); \
    t0 = __uint_as_float(_r3[0]); t1 = __uint_as_float(_r3[1]); } while (0)
  u32* ybuf = (u32*)(shm + RW_YBUF) + j * (RB * 8);
  RW_LOAD(0); RW_WRITE(0);
  group_barrier(cnt, gen, lane);
  for (int n = 0; n < SEQ / RB; ++n) {
    if (n + 1 < SEQ / RB) RW_LOAD(n + 1);
    int boff = RW_OFF + (n & 1) * RB * RW_STEP + q8 * 32;
    asm volatile("" : "+v"(boff));
    const char* bufb = shm + boff;
    const int voff = 1280 - q8 * 32 + (16 * j + 2 * rp) * 4;
    f32x4 k4[2]; f32x2 vv;
    k4[0] = ((const f32x4*)bufb)[0]; k4[1] = ((const f32x4*)bufb)[1];
    vv = *(const f32x2*)(bufb + voff);
#pragma unroll
    for (int s = 0; s < RB; ++s) {
      const f32x4* P = (const f32x4*)(bufb + s * RW_STEP);
      f32x4 w4[2], b4[2], d4[2], r4[2];
#pragma unroll
      for (int i = 0; i < 2; ++i) { w4[i] = P[16 + i]; b4[i] = P[32 + i]; d4[i] = P[48 + i]; r4[i] = P[64 + i]; }
      float a0, a1;
      FMUL(a0, S0[0], k4[0][0]); FMUL(a1, S1[0], k4[0][0]);
#pragma unroll
      for (int i = 1; i < 8; ++i) { FMAC(a0, S0[i], k4[i >> 2][i & 3]); FMAC(a1, S1[i], k4[i >> 2][i & 3]); }
      float t0, t1;
      REDUCE2(a0, a1, t0, t1);
      const float ns0 = -t0, ns1 = -t1;
      const float v0 = vv[0], v1 = vv[1];
      if (s + 1 < RB) {
        k4[0] = ((const f32x4*)(bufb + (s + 1) * RW_STEP))[0]; k4[1] = ((const f32x4*)(bufb + (s + 1) * RW_STEP))[1];
        vv = *(const f32x2*)(bufb + (s + 1) * RW_STEP + voff);
      }
#pragma unroll
      for (int i = 0; i < 8; ++i) {
        FMUL(S0[i], S0[i], w4[i >> 2][i & 3]); FMUL(S1[i], S1[i], w4[i >> 2][i & 3]);
        FMAC(S0[i], ns0, b4[i >> 2][i & 3]);   FMAC(S1[i], ns1, b4[i >> 2][i & 3]);
        FMAC(S0[i], v0, d4[i >> 2][i & 3]);    FMAC(S1[i], v1, d4[i >> 2][i & 3]);
      }
      float y0, y1;
      FMUL(y0, S0[0], r4[0][0]); FMUL(y1, S1[0], r4[0][0]);
#pragma unroll
      for (int i = 1; i < 8; ++i) { FMAC(y0, S0[i], r4[i >> 2][i & 3]); FMAC(y1, S1[i], r4[i >> 2][i & 3]); }
      float yt0, yt1;
      REDUCE2(y0, y1, yt0, yt1);
      ybuf[s * 8 + rp] = pack2(yt0, yt1);
    }
    asm volatile("s_waitcnt lgkmcnt(0)" ::: "memory");
#pragma unroll
    for (int u = 0; u < 2; ++u) {
      const int s = (lane >> 3) + 8 * u;
      *(u32*)(yr + (tok0 + dstep * (n * RB + s)) * 512 + h * 64 + 16 * j + 2 * rp) = ybuf[s * 8 + rp];
    }
    if (n + 1 < SEQ / RB) RW_WRITE(n + 1);
    group_barrier(cnt, gen, lane);
  }
#undef REDUCE2
#undef FMAC
#undef FMUL
#undef RW_LOAD
#undef RW_WRITE
}

__device__ __forceinline__ void group_barrier(int* cnt, int& gen, int lane) {
  __builtin_amdgcn_fence(__ATOMIC_RELEASE, "workgroup");
  gen += 4;
  if (lane == 0) __hip_atomic_fetch_add(cnt, 1, __ATOMIC_RELAXED, __HIP_MEMORY_SCOPE_WORKGROUP);
  while (__hip_atomic_load(cnt, __ATOMIC_RELAXED, __HIP_MEMORY_SCOPE_WORKGROUP) < gen) __builtin_amdgcn_s_sleep(1);
  __builtin_amdgcn_fence(__ATOMIC_ACQUIRE, "workgroup");
}

constexpr int LC = 64;
constexpr int ST128 = 136, ST64 = 72;
constexpr int SSD_SC = 0, SSD_SB = 17408, SSD_SBT = 34816, SSD_SXT = 53248, SSD_SM = 62464, SSD_SH = 71680, SSD_CNT = 89088;

__device__ void ssd_item(const PV& p, int l, int item, int tid  , char* shm, int& gen) {
  const int d = item >> 7, b = (item >> 3) & 15, h = item & 7, g = h >> 2;
  const int w4 = tid >> 6, lane = tid & 63, wr = w4 >> 1, wc = w4 & 1, l31 = lane & 31, hi = lane >> 5;
  u16* sC = (u16*)(shm + SSD_SC); u16* sB = (u16*)(shm + SSD_SB); u16* sBT = (u16*)(shm + SSD_SBT);
  u16* sXT = (u16*)(shm + SSD_SXT); u16* sM = (u16*)(shm + SSD_SM); u16* sH = (u16*)(shm + SSD_SH);
  int* cnt = (int*)(shm + SSD_CNT);
  const u16* xs = (const u16*)(p.ws() + OFF_XS); const u16* Bm = (const u16*)(p.ws() + OFF_BM); const u16* Cm = (const u16*)(p.ws() + OFF_CM);
  const float* dt = (const float*)(p.ws() + OFF_DT);
  u16* ys = (u16*)(p.ws() + OFF_S) + (size_t)d * MTOK * 512;
  const float Aneg = -__expf(p.in(IALOG)[l * 16 + d * 8 + h]);
  for (int i = tid; i < 64 * ST128 / 2; i += 256) ((u32*)sH)[i] = 0u;
  f32x16 Hacc[2];
#pragma unroll
  for (int i = 0; i < 16; ++i) { Hacc[0][i] = 0.f; Hacc[1][i] = 0.f; }

  for (int ci = 0; ci < SEQ / LC; ++ci) {
    const int c = d ? (SEQ / LC - 1 - ci) : ci;
    const long tokbase = (long)b * SEQ + c * LC;
#define TOK(lr) (tokbase + (d ? (LC - 1 - (lr)) : (lr)))
    const float dtv = dt[TOK(lane) * 16 + d * 8 + h];
    float cs = dtv * Aneg;
#pragma unroll
    for (int o = 1; o < 64; o <<= 1) { float t = __shfl_up(cs, o); if (lane >= o) cs += t; }
    const float cs_last = __shfl(cs, 63);
#pragma unroll
    for (int i = 0; i < 4; ++i) {
      int idx = tid + 256 * i, row = idx & 63, seg = idx >> 6;
      long tk = TOK(row);
      uint4 cvv = *(const uint4*)(Cm + tk * 256 + g * 128 + seg * 8);
      uint4 bvv = *(const uint4*)(Bm + tk * 256 + g * 128 + seg * 8);
      *(uint4*)(sC + row * ST128 + seg * 8) = cvv;
      *(uint4*)(sB + row * ST128 + seg * 8) = bvv;
      float dec = __expf(cs_last - cs);
      u32 bw[4] = {bvv.x, bvv.y, bvv.z, bvv.w};
#pragma unroll
      for (int q = 0; q < 4; ++q) {
        sBT[(seg * 8 + 2 * q) * ST64 + row] = f2bf(bflo(bw[q]) * dec);
        sBT[(seg * 8 + 2 * q + 1) * ST64 + row] = f2bf(bfhi(bw[q]) * dec);
      }
    }
#pragma unroll
    for (int i = 0; i < 2; ++i) {
      int idx = tid + 256 * i, row = idx & 63, seg = idx >> 6;
      long tk = TOK(row);
      uint4 xv = *(const uint4*)(xs + tk * 512 + h * 64 + seg * 8);
      float dts = dtv;
      u32 xw[4] = {xv.x, xv.y, xv.z, xv.w};
#pragma unroll
      for (int q = 0; q < 4; ++q) {
        sXT[(seg * 8 + 2 * q) * ST64 + row] = f2bf(bflo(xw[q]) * dts);
        sXT[(seg * 8 + 2 * q + 1) * ST64 + row] = f2bf(bfhi(xw[q]) * dts);
      }
    }
    group_barrier(cnt, gen, lane);
    {
      f32x16 acc;
#pragma unroll
      for (int i = 0; i < 16; ++i) acc[i] = 0.f;
#pragma unroll
      for (int kb = 0; kb < 8; ++kb) {
        bf16x8 a = *(const bf16x8*)(sC + (32 * wr + l31) * ST128 + kb * 16 + hi * 8);
        bf16x8 bb = *(const bf16x8*)(sB + (32 * wc + l31) * ST128 + kb * 16 + hi * 8);
        acc = __builtin_amdgcn_mfma_f32_32x32x16_bf16(a, bb, acc, 0, 0, 0);
      }
      const int s = 32 * wc + l31;
      const float cs_s = __shfl(cs, s);
#pragma unroll
      for (int i = 0; i < 16; ++i) {
        int lrow = 32 * wr + 8 * (i >> 2) + 4 * hi + (i & 3);
        const int lr0 = 32 * wr + 8 * (i >> 2) + (i & 3);
        float cs_l = __uint_as_float(hi ? __builtin_amdgcn_readlane(__float_as_uint(cs), lr0 + 4) : __builtin_amdgcn_readlane(__float_as_uint(cs), lr0));
        float m = (s <= lrow) ? acc[i] * __expf(cs_l - cs_s) : 0.f;
        sM[lrow * ST64 + s] = f2bf(m);
      }
    }
    group_barrier(cnt, gen, lane);
    {
      f32x16 acc1, acc2;
#pragma unroll
      for (int i = 0; i < 16; ++i) { acc1[i] = 0.f; acc2[i] = 0.f; }
#pragma unroll
      for (int kb = 0; kb < 4; ++kb) {
        bf16x8 a = *(const bf16x8*)(sM + (32 * wr + l31) * ST64 + kb * 16 + hi * 8);
        bf16x8 bb = *(const bf16x8*)(sXT + (32 * wc + l31) * ST64 + kb * 16 + hi * 8);
        acc1 = __builtin_amdgcn_mfma_f32_32x32x16_bf16(a, bb, acc1, 0, 0, 0);
      }
#pragma unroll
      for (int kb = 0; kb < 8; ++kb) {
        bf16x8 a = *(const bf16x8*)(sC + (32 * wr + l31) * ST128 + kb * 16 + hi * 8);
        bf16x8 bb = *(const bf16x8*)(sH + (32 * wc + l31) * ST128 + kb * 16 + hi * 8);
        acc2 = __builtin_amdgcn_mfma_f32_32x32x16_bf16(a, bb, acc2, 0, 0, 0);
      }
      const int pcol = h * 64 + 32 * wc + l31;
#pragma unroll
      for (int i = 0; i < 16; ++i) {
        int lrow = 32 * wr + 8 * (i >> 2) + 4 * hi + (i & 3);
        const int lr0 = 32 * wr + 8 * (i >> 2) + (i & 3);
        const float cs_l = __uint_as_float(hi ? __builtin_amdgcn_readlane(__float_as_uint(cs), lr0 + 4) : __builtin_amdgcn_readlane(__float_as_uint(cs), lr0));
        float y = acc1[i] + __expf(cs_l) * acc2[i];
        ys[TOK(lrow) * 512 + pcol] = f2bf(y);
      }
    }
    group_barrier(cnt, gen, lane);
    {
      const float dall = __expf(cs_last);
#pragma unroll
      for (int nt = 0; nt < 2; ++nt) {
#pragma unroll
        for (int i = 0; i < 16; ++i) Hacc[nt][i] *= dall;
#pragma unroll
        for (int kb = 0; kb < 4; ++kb) {
          bf16x8 a = *(const bf16x8*)(sXT + (32 * wr + l31) * ST64 + kb * 16 + hi * 8);
          bf16x8 bb = *(const bf16x8*)(sBT + (64 * wc + 32 * nt + l31) * ST64 + kb * 16 + hi * 8);
          Hacc[nt] = __builtin_amdgcn_mfma_f32_32x32x16_bf16(a, bb, Hacc[nt], 0, 0, 0);
        }
#pragma unroll
        for (int i = 0; i < 16; ++i) {
          int prow = 32 * wr + 8 * (i >> 2) + 4 * hi + (i & 3);
          sH[prow * ST128 + 64 * wc + 32 * nt + l31] = f2bf(Hacc[nt][i]);
        }
      }
    }
    group_barrier(cnt, gen, lane);
#undef TOK
  }
}

__device__ void mixer_phase(const Ctx c, const PV& p, int l, char* shm) {
  int* cnt = (int*)(shm + SSD_CNT);
  int* cnt2 = (int*)(shm + RW_CNT);
  if (c.tid == 0) { *cnt = 0; *cnt2 = 0; }
  __syncthreads();
  int gen = 0;
  if (c.tid < 256) {
    for (int rep = 0; rep < ((PROBE_MIX & 1) ? 2 : 1); ++rep)
    for (int it = c.bid; it < 256; it += c.nb) rwkv_scan(p, l, it, c.tid, shm, gen);
  } else {
    for (int rep = 0; rep < ((PROBE_MIX & 2) ? 2 : 1); ++rep)
    for (int it = c.bid; it < 256; it += c.nb) ssd_item(p, l, it, c.tid - 256, shm, gen);
  }
}

__device__ void post_phase(const Ctx c, const PV& p, int l) {
  const int wave = c.tid >> 6, lane = c.tid & 63;
  const u16* xs = (const u16*)(p.ws() + OFF_XS); const u16* sz = (const u16*)(p.ws() + OFF_SZ);
  const u16* ys = (const u16*)(p.ws() + OFF_S);
  const u16* yr = (const u16*)(p.ws() + OFF_YR);
  const u16* rr = (const u16*)(p.ws() + OFF_R); const u16* kk_ = (const u16*)(p.ws() + OFF_K); const u16* vv = (const u16*)(p.ws() + OFF_V);
  const u16* aa = (const u16*)(p.ws() + OFF_A); const u16* gg = (const u16*)(p.ws() + OFF_G);
  u16* ymix = (u16*)(p.ws() + OFF_YMIX);
  const float* dskip = p.in(IDSKIP) + l * 8;
  const float* ng = p.in(ISSDG) + (size_t)l * 512;
  const float* ka = p.in(IKA) + (size_t)l * 512; const float* rk = p.in(IRK) + (size_t)l * 512;
  const float* lg = p.in(ILNXG) + (size_t)l * 512; const float* lb = p.in(ILNXB) + (size_t)l * 512;
  const int c0 = lane * 8;
  float ngv[8], kav[8], rkv[8], lgv[8], lbv[8];
#pragma unroll
  for (int e = 0; e < 8; ++e) { ngv[e] = ng[c0 + e]; kav[e] = ka[c0 + e]; rkv[e] = rk[c0 + e]; lgv[e] = lg[c0 + e]; lbv[e] = lb[c0 + e]; }
  const float ds = dskip[lane >> 3];
#define POST_LOAD(D, tok_) do { const size_t o_ = (size_t)(tok_) * 512 + c0; \
    D[0] = ldnt16(ys + o_); D[1] = ldnt16(ys + (size_t)MTOK * 512 + o_); \
    D[2] = ldnt16(xs + o_); D[3] = ldnt16(sz + o_); \
    D[4] = ldnt16(yr + o_); D[5] = ldnt16(yr + (size_t)MTOK * 512 + o_); \
    D[6] = ldnt16(rr + o_); D[7] = ldnt16(kk_ + o_); D[8] = ldnt16(vv + o_); D[9] = ldnt16(gg + o_); \
    D[10] = ldnt16(aa + o_); D[11] = ldnt16(aa + (size_t)MTOK * 512 + o_); } while (0)
  int tok = c.bid * 8 + wave;
  uint4 L[12], N[12];
  if (tok < MTOK) POST_LOAD(L, tok);
  for (; tok < MTOK; tok += c.nb * 8) {
    const int ntok = tok + c.nb * 8;
    if (ntok < MTOK) POST_LOAD(N, ntok);
    {
      float f[8], bk[8], x[8], z[8];
      unpack8(L[0], f); unpack8(L[1], bk); unpack8(L[2], x); unpack8(L[3], z);
      float y[8]; float ss = 0.f;
#pragma unroll
      for (int e = 0; e < 8; ++e) { y[e] = (f[e] + bk[e] + ds * x[e]) * z[e]; ss += y[e] * y[e]; }
#pragma unroll
      for (int off = 16; off >= 1; off >>= 1) ss += __shfl_xor(ss, off);
      const float rs = rsqrtf(ss * (1.f / 256.f) + RMS_EPS);
      float ov[8];
#pragma unroll
      for (int e = 0; e < 8; ++e) ov[e] = y[e] * rs * ngv[e];
      *(uint4*)(ymix + (size_t)tok * 1024 + c0) = pack8(ov);
    }
    {
      float yf[8], yb[8], r[8], k[8], vf[8], gf[8], af[8], ab[8];
      unpack8(L[4], yf); unpack8(L[5], yb); unpack8(L[6], r); unpack8(L[7], k); unpack8(L[8], vf); unpack8(L[9], gf);
      unpack8(L[10], af); unpack8(L[11], ab);
      float y[8]; float sum = 0.f, bon = 0.f;
#pragma unroll
      for (int e = 0; e < 8; ++e) {
        y[e] = yf[e] + yb[e]; sum += y[e];
        bon += r[e] * k[e] * rkv[e] * (2.f + (af[e] + ab[e] - 2.f) * kav[e]);
      }
#pragma unroll
      for (int off = 4; off >= 1; off >>= 1) { sum += __shfl_xor(sum, off); bon += __shfl_xor(bon, off); }
      const float mean = sum * (1.f / 64.f);
      float sq = 0.f;
#pragma unroll
      for (int e = 0; e < 8; ++e) { float dlt = y[e] - mean; sq += dlt * dlt; }
#pragma unroll
      for (int off = 4; off >= 1; off >>= 1) sq += __shfl_xor(sq, off);
      const float rstd = rsqrtf(sq * (1.f / 64.f) + GN_EPS);
      float ov[8];
#pragma unroll
      for (int e = 0; e < 8; ++e) ov[e] = ((y[e] - mean) * rstd * lgv[e] + lbv[e] + bon * vf[e]) * gf[e];
      *(uint4*)(ymix + (size_t)tok * 1024 + 512 + c0) = pack8(ov);
    }
#pragma unroll
    for (int i = 0; i < 12; ++i) L[i] = N[i];
  }
#undef POST_LOAD
}

#define XB_TMO      128
#define XB_XCNT(j)  (256  + 64 * (j))
#define XB_XSUB(j)  (1280 + 64 * (j))
#define XB_XGEN(j)  (2304 + 64 * (j))
#define XB_TOP      3328
#define XB_TOPGEN   3392
#define XCD_BAR_WORDS 3456
#define XB_SPIN_CAP (1u << 18)
#define LAS __attribute__((address_space(3)))

__device__ __forceinline__ unsigned xb_ld(unsigned* p)              { return __hip_atomic_load(p, __ATOMIC_RELAXED, __HIP_MEMORY_SCOPE_AGENT); }
__device__ __forceinline__ unsigned xb_add(unsigned* p, unsigned v) { return __hip_atomic_fetch_add(p, v, __ATOMIC_RELAXED, __HIP_MEMORY_SCOPE_AGENT); }
__device__ __forceinline__ unsigned xb_xcc_id() { return (unsigned)__builtin_amdgcn_s_getreg((3 << 11) | 20) & 0xFu; }
#define XB_SPIN(cond, bar) do { unsigned _sp = 0; while (cond) { __builtin_amdgcn_s_sleep(1); \
    if ((++_sp & 255u) == 0u) { if (xb_ld(&(bar)[XB_TMO])) break; if (_sp > XB_SPIN_CAP) { atomicAdd(&(bar)[XB_TMO], 1u); break; } } } } while (0)

struct XcdBarrier {
    unsigned* bar; unsigned x; unsigned wv;
    volatile LAS unsigned* st;
};

__device__ __forceinline__ XcdBarrier xcd_barrier_post(unsigned* bar, volatile LAS unsigned* st) {
    XcdBarrier b; b.bar = bar; b.x = xb_xcc_id(); b.st = st; b.wv = (unsigned)__builtin_amdgcn_readfirstlane((int)(threadIdx.x >> 6));
    if (threadIdx.x == 0) (void)xb_add(&bar[XB_XCNT(b.x)], 1u);
    return b;
}
__device__ __forceinline__ void xcd_barrier_complete(unsigned* bar, unsigned x, unsigned& nloc, unsigned& nx) {
    const unsigned G = gridDim.x * gridDim.y * gridDim.z;
    unsigned sum, cnt, mine, sp = 0u;
    for (;;) {
        sum = 0u; cnt = 0u; mine = 0u;
#pragma unroll
        for (unsigned j = 0; j < 16; ++j) { const unsigned c = xb_ld(&bar[XB_XCNT(j)]); sum += c; cnt += (c > 0u) ? 1u : 0u; mine = (j == x) ? c : mine; }
        if (sum == G) break;
        __builtin_amdgcn_s_sleep(1);
        if ((++sp & 255u) == 0u) { if (xb_ld(&bar[XB_TMO])) break; if (sp > XB_SPIN_CAP) { atomicAdd(&bar[XB_TMO], 1u); break; } }
    }
    nloc = mine > 0u ? mine : 1u; nx = cnt > 0u ? cnt : 1u;
}

__device__ __forceinline__ void xcd_barrier(const XcdBarrier& b) {
    asm volatile("s_waitcnt vmcnt(0)" ::: "memory");
    __syncthreads();
    if (b.wv == 0u && lane_id_() == 0) {
        unsigned* bar = b.bar;
        __builtin_amdgcn_s_waitcnt(0);
        unsigned nloc = b.st[0], nx = b.st[1];
        if (nloc == 0u) { xcd_barrier_complete(bar, b.x, nloc, nx); b.st[0] = nloc; b.st[1] = nx; }
        const unsigned old = xb_add(&bar[XB_XSUB(b.x)], 1u);
        const unsigned gen = old / nloc;
        if (old + 1u == (gen + 1u) * nloc) {
            __builtin_amdgcn_fence(__ATOMIC_RELEASE, "agent");
            asm volatile("s_waitcnt vmcnt(0)" ::: "memory");
            const unsigned og = xb_add(&bar[XB_TOP], 1u);
            const unsigned tg = og / nx;
            if (og + 1u == (tg + 1u) * nx) xb_add(&bar[XB_TOPGEN], 1u);
            else XB_SPIN(xb_ld(&bar[XB_TOPGEN]) == tg, bar);
            __builtin_amdgcn_fence(__ATOMIC_ACQUIRE, "agent");
            xb_add(&bar[XB_XGEN(b.x)], 1u);
            asm volatile("s_waitcnt vmcnt(0)" ::: "memory");
        } else {
            XB_SPIN(xb_ld(&bar[XB_XGEN(b.x)]) == gen, bar);
            __builtin_amdgcn_fence(__ATOMIC_ACQUIRE, "agent");
            asm volatile("s_waitcnt vmcnt(0)" ::: "memory");
        }
    }
    __syncthreads();
}


constexpr int NPHASE = 21;

__device__ __forceinline__ void run_phase(const Ctx c, const PV& p, int ph, char* shm) {
  const int l = (ph == 0) ? 0 : (ph - 1) / 10, s = (ph == 0) ? -1 : (ph - 1) % 10;
  if (s == 0 || s == 2 || s == 5 || s == 7 || s == 8) {
    GemmDesc gd{};
    gd.eproj = EpiProj{(u16*)(p.ws() + OFF_P), (float*)(p.ws() + OFF_DTRAW)};
    gd.elora = EpiLora{(u16*)(p.ws() + OFF_E), (u16*)(p.ws() + OFF_A), (u16*)(p.ws() + OFF_G), p.in(IW0) + (size_t)l * 1024, p.in(IA0) + (size_t)l * 1024};
    gd.eresh = EpiResidB{(u16*)(p.ws() + OFF_PRE), (const u16*)p.out()};
    gd.eresb = EpiResidB{(u16*)(p.ws() + OFF_PRE), (const u16*)(p.ws() + OFF_H)};
    gd.erelu = EpiRelu2{(u16*)(p.ws() + OFF_ACT)};
    if (s == 0)      { gd.A = (const u16*)(p.ws() + OFF_H);    gd.Bt = (const u16*)(p.ws() + OFF_WIN);   gd.N = NPROJ; gd.K = DM;  gd.kind = 0; }
    else if (s == 2) { gd.A = (const u16*)(p.ws() + OFF_S);    gd.Bt = (const u16*)(p.ws() + OFF_WLORA); gd.N = 2560;  gd.K = 256; gd.kind = 1; }
    else if (s == 5) { gd.A = (const u16*)(p.ws() + OFF_YMIX); gd.Bt = (const u16*)(p.ws() + OFF_WOUT);  gd.N = DM;    gd.K = DM;  gd.kind = 2; }
    else if (s == 7) { gd.A = (const u16*)(p.ws() + OFF_H);    gd.Bt = (const u16*)(p.ws() + OFF_WFC);   gd.N = DFF;   gd.K = DM;  gd.kind = 3; }
    else             { gd.A = (const u16*)(p.ws() + OFF_ACT);  gd.Bt = (const u16*)(p.ws() + OFF_WPROJ); gd.N = DM;    gd.K = DFF; gd.kind = 4; }
    gemm_phase(c, gd, shm);
    return;
  }
  switch (s) {
    case -1:
#if PROBE_CLK
      if (c.tid < 256) {
        float a = (float)c.tid, b = 1.0000001f, cc = 1e-9f;
        for (int it = 0; it < 32768; ++it) { a = rowsum4(a) * b + cc; }
        if (a == 12345.678f) p.out()[0] = a;
      }
#endif
      ln_phase(c, p.in(IX), p.in(ILN0G), p.in(ILN0B), p.out(), (u16*)(p.ws() + OFF_H));
      convert_weights(c, p, 0, shm);
      break;
    case 1: prep_phase(c, p, l); break;
    case 3: mixer_phase(c, p, l, shm); break;
    case 4: post_phase(c, p, l); break;
    case 6: ln_phase_b(c, (const u16*)(p.ws() + OFF_PRE), p.in(ILN1G) + (size_t)l * DM, p.in(ILN1B) + (size_t)l * DM, p.out(), (u16*)(p.ws() + OFF_H), false, true, false); break;
    case 9:
      ln_phase_b(c, (const u16*)(p.ws() + OFF_PRE), p.in(ILN2G) + (size_t)l * DM, p.in(ILN2B) + (size_t)l * DM, p.out(), (u16*)(p.ws() + OFF_H), l != 0, l == 0, l == 0);
      if (l == 0) convert_weights(c, p, 1, shm);
      break;
    default: break;
  }
}

__global__ void __launch_bounds__(512) mega(Params p, int lo, int hi) {
  extern __shared__ __attribute__((aligned(16))) char shm[];
  volatile LAS unsigned* xst = (volatile LAS unsigned*)(shm + XB_LDS_OFF);
  if (threadIdx.x == 0) { xst[0] = 0u; xst[1] = 0u; xst[2] = 0u; xst[3] = 0u; }
  __syncthreads();
  XcdBarrier xb = xcd_barrier_post((unsigned*)(p.ws + OFF_BAR), xst);
  if (hi > 1000) cg::this_grid().sync();
#if PROBE_SYNC
  if (hi - lo > 1) { for (int i = 0; i < 20; ++i) xcd_barrier(xb); }
#endif
  for (int ph = lo; ph < hi; ++ph) {
    int reps = 1;
#if PROBE_REP
    if (ph > 0 && ((PROBE_REP >> ((ph - 1) % 10)) & 1)) reps = 2;
#endif
    for (int rep = 0; rep < reps; ++rep) {
      long z; int zi;
      asm volatile("s_mov_b64 %0, 0\n\ts_mov_b32 %1, 0" : "=s"(z), "=s"(zi));
      const PV q{p, z};
      int tidv = (int)xb.wv * 64 + lane_id_(); asm volatile("" : "+v"(tidv));
      Ctx c{tidv, (int)blockIdx.x + zi, (int)gridDim.x + zi};
      run_phase(c, q, ph, shm);
      if (rep + 1 < reps || ph + 1 < hi) { xcd_barrier(xb); }
    }
  }
}

extern "C" void kernel_launch(void* const* d_in, const int* in_sizes, int n_in, void* d_out, int out_size,
                              void* d_ws, size_t ws_size, hipStream_t stream) {
  if (ws_size < WS_NEED) { fprintf(stderr, "workspace too small: %zu < %zu\n", ws_size, WS_NEED); return; }
  Params p{};
  for (int i = 0; i < NIN; ++i) p.in[i] = (const float*)d_in[i];
  p.out = (float*)d_out;
  p.ws = (char*)d_ws;
  hipFuncSetAttribute((const void*)mega, hipFuncAttributeMaxDynamicSharedMemorySize, SHM_BYTES);
#if COOP
  hipMemsetAsync((char*)d_ws + OFF_BAR, 0, XCD_BAR_WORDS * sizeof(unsigned), stream);
  int lo = 0, hi = NPHASE;
  void* args[] = {&p, &lo, &hi};
  hipError_t e = hipLaunchCooperativeKernel((const void*)mega, dim3(256), dim3(512), args, SHM_BYTES, stream);
  if (e != hipSuccess) fprintf(stderr, "cooperative launch failed: %s\n", hipGetErrorString(e));
#else
  for (int ph = 0; ph < NPHASE; ++ph) mega<<<dim3(256), dim3(512), SHM_BYTES, stream>>>(p, ph, ph + 1);
#endif
}
```

```cpp
#include <hip/hip_runtime.h>
#include <hip/hip_bf16.h>
#include <hip/hip_cooperative_groups.h>
#include <cstdio>
namespace cg = cooperative_groups;

#ifndef COOP
#define COOP 1
#endif
#define PROBE_MIX 0
#define PROBE_CLK 0
#define PROBE_SYNC 0
#define GEMM_REGSTAGE 0
#define PROBE_REP 0x000

typedef unsigned short u16;
typedef unsigned int u32;
using bf16x8 = __attribute__((ext_vector_type(8))) short;
using f32x4 = __attribute__((ext_vector_type(4))) float;
using f32x16 = __attribute__((ext_vector_type(16))) float;
using i32x4 = __attribute__((ext_vector_type(4))) int;

constexpr int MTOK = 32768, SEQ = 2048, DM = 1024, DFF = 4096;
constexpr int NPROJ = 3584;
constexpr int SSD_COLS = 1552;
constexpr float ALPHA = 1.4142135623730951f;
constexpr float LN_EPS = 1e-5f, RMS_EPS = 1e-5f, GN_EPS = 64e-5f;

enum { IX=0, ILN0G, ILN0B, IWIN, ICONVW, ICONVB, IDTB, IALOG, IDSKIP, ISSDG, IMU, IW0, IWUP, IA0, IAUP, IGUP,
       IKK, IKA, IRK, ILNXG, ILNXB, IWOUT, ILN1G, ILN1B, IWFC, IWPROJ, ILN2G, ILN2B, NIN };

constexpr size_t OFF_WIN = 0;
constexpr size_t OFF_WOUT = 7340032;
constexpr size_t OFF_WFC = 9437184;
constexpr size_t OFF_WPROJ = 17825792;
constexpr size_t OFF_WLORA = 26214400;
constexpr size_t OFF_H = 27525120;
constexpr size_t OFF_XS = OFF_H;
constexpr size_t OFF_BM = OFF_H + 33554432;
constexpr size_t OFF_CM = OFF_H + 50331648;
constexpr size_t OFF_P = OFF_H + 67108864;
constexpr size_t OFF_E = OFF_P;
constexpr size_t OFF_A = OFF_P + 67108864;
constexpr size_t OFF_G = OFF_P + 134217728;
constexpr size_t OFF_YR = OFF_P + 167772160;
constexpr size_t OFF_YMIX = OFF_P;
constexpr size_t OFF_ACT = OFF_P;
constexpr size_t OFF_S = OFF_P + 234881024;
constexpr size_t OFF_Q = OFF_S + 67108864;
constexpr size_t OFF_R = OFF_Q;
constexpr size_t OFF_K = OFF_Q + 33554432;
constexpr size_t OFF_V = OFF_Q + 67108864;
constexpr size_t OFF_SZ = OFF_Q + 100663296;
constexpr size_t OFF_PRE = OFF_Q;
constexpr size_t OFF_SM = OFF_Q + 134217728;
constexpr size_t OFF_DT = OFF_SM;
constexpr size_t OFF_INVN = OFF_SM + 2097152;
constexpr size_t OFF_DTRAW = OFF_S + 50331648;
constexpr size_t OFF_BAR = OFF_SM + 4194304;
constexpr size_t WS_NEED = OFF_BAR + 16384;

struct Params {
  const float* in[NIN];
  float* out;
  char* ws;
};
struct Ctx { int tid, bid, nb; };
__device__ __forceinline__ int lane_id_() { int l; asm volatile("v_mbcnt_lo_u32_b32 %0, -1, 0\n\tv_mbcnt_hi_u32_b32 %0, -1, %0" : "=v"(l)); return l; }
struct PV {
  const Params& pr; long z;
  __device__ __forceinline__ const float* in(int i) const { return pr.in[i] + z; }
  __device__ __forceinline__ char* ws() const { return pr.ws + z; }
  __device__ __forceinline__ float* out() const { return pr.out + z; }
};

typedef __bf16 hwbf16x2 __attribute__((ext_vector_type(2)));
typedef float hwf32x2 __attribute__((ext_vector_type(2)));
__device__ __forceinline__ u16 f2bf(float f) { __bf16 r = (__bf16)f; return __builtin_bit_cast(u16, r); }
__device__ __forceinline__ float bf2f(u16 h) { return __uint_as_float(((u32)h) << 16); }
__device__ __forceinline__ float bflo(u32 w) { return __uint_as_float(w << 16); }
__device__ __forceinline__ float bfhi(u32 w) { return __uint_as_float(w & 0xffff0000u); }
__device__ __forceinline__ u32 pack2(float a, float b) { hwf32x2 v{a, b}; hwbf16x2 r = __builtin_convertvector(v, hwbf16x2); return __builtin_bit_cast(u32, r); }
__device__ __forceinline__ float sigmoidf_(float x) { return __builtin_amdgcn_rcpf(1.f + __expf(-x)); }
__device__ __forceinline__ float siluf_(float x) { return x * __builtin_amdgcn_rcpf(1.f + __expf(-x)); }
__device__ __forceinline__ float tanhf_(float x) { return 1.f - 2.f * __builtin_amdgcn_rcpf(1.f + __expf(2.f * x)); }
__device__ __forceinline__ float softplusf_(float x) { return fmaxf(x, 0.f) + log1pf(__expf(-fabsf(x))); }
__device__ __forceinline__ uint4 ldnt16(const void* p) {
  i32x4 v = __builtin_nontemporal_load((const i32x4*)p);
  return make_uint4((u32)v[0], (u32)v[1], (u32)v[2], (u32)v[3]);
}
__device__ __forceinline__ float4 ldnt16f(const void* p) {
  uint4 v = ldnt16(p);
  return make_float4(__uint_as_float(v.x), __uint_as_float(v.y), __uint_as_float(v.z), __uint_as_float(v.w));
}
__device__ __forceinline__ float wave_sum(float v) {
#pragma unroll
  for (int o = 32; o >= 1; o >>= 1) v += __shfl_xor(v, o);
  return v;
}

__device__ __forceinline__ uint4 pack8v(f32x4 a, f32x4 b) {
  uint4 o; o.x = pack2(a[0], a[1]); o.y = pack2(a[2], a[3]); o.z = pack2(b[0], b[1]); o.w = pack2(b[2], b[3]);
  return o;
}
struct EpiProj {
  u16* proj; float* dt;
  __device__ __forceinline__ void operator()(int row, int col, f32x4 v, f32x4 w) const {
    *(uint4*)(proj + (size_t)row * NPROJ + col) = pack8v(v, w);
    if (col >= 1536 && col < 1552) { f32x4* d = (f32x4*)(dt + (size_t)row * 16 + (col - 1536)); d[0] = v; d[1] = w; }
  }
};
struct EpiLora {
  u16* e; u16* a; u16* g; const float* w0; const float* a0;
  __device__ __forceinline__ void operator()(int row, int col, f32x4 v, f32x4 w) const {
    if (col < 1024) {
      int d = col >> 9, c = col & 511;
      f32x4 b0 = *(const f32x4*)(w0 + col), b1 = *(const f32x4*)(w0 + col + 4);
      f32x4 o0, o1;
#pragma unroll
      for (int j = 0; j < 4; ++j) { o0[j] = 0.6065306597126334f * sigmoidf_(b0[j] + v[j]); o1[j] = 0.6065306597126334f * sigmoidf_(b1[j] + w[j]); }
      *(uint4*)(e + ((size_t)d * MTOK + row) * 512 + c) = pack8v(o0, o1);
    } else if (col < 2048) {
      int cc = col - 1024, d = cc >> 9, c = cc & 511;
      f32x4 b0 = *(const f32x4*)(a0 + cc), b1 = *(const f32x4*)(a0 + cc + 4);
      f32x4 o0, o1;
#pragma unroll
      for (int j = 0; j < 4; ++j) { o0[j] = sigmoidf_(b0[j] + v[j]); o1[j] = sigmoidf_(b1[j] + w[j]); }
      *(uint4*)(a + ((size_t)d * MTOK + row) * 512 + c) = pack8v(o0, o1);
    } else {
      *(uint4*)(g + (size_t)row * 512 + (col - 2048)) = pack8v(v, w);
    }
  }
};
struct EpiResid {
  u16* pre; const float* h;
  __device__ __forceinline__ void operator()(int row, int col, f32x4 v, f32x4 w) const {
    size_t o = (size_t)row * DM + col;
    f32x4 h0 = *(const f32x4*)(h + o), h1 = *(const f32x4*)(h + o + 4);
    *(uint4*)(pre + o) = pack8v(h0 * ALPHA + v, h1 * ALPHA + w);
  }
};
struct EpiResidB {
  u16* pre; const u16* hb;
  __device__ __forceinline__ void operator()(int row, int col, f32x4 v, f32x4 w) const {
    size_t o = (size_t)row * DM + col;
    uint4 hv = ldnt16(hb + o);
    f32x4 h0 = f32x4{bflo(hv.x), bfhi(hv.x), bflo(hv.y), bfhi(hv.y)}, h1 = f32x4{bflo(hv.z), bfhi(hv.z), bflo(hv.w), bfhi(hv.w)};
    *(uint4*)(pre + o) = pack8v(h0 * ALPHA + v, h1 * ALPHA + w);
  }
};
struct EpiRelu2 {
  u16* act;
  __device__ __forceinline__ void operator()(int row, int col, f32x4 v, f32x4 w) const {
    f32x4 r0, r1;
#pragma unroll
    for (int j = 0; j < 4; ++j) { float a = fmaxf(v[j], 0.f), b = fmaxf(w[j], 0.f); r0[j] = a * a; r1[j] = b * b; }
    *(uint4*)(act + (size_t)row * DFF + col) = pack8v(r0, r1);
  }
};

constexpr int BM = 256, BN = 256, BK = 64, NXCD = 8, WGM = 8;
constexpr int SHM_BYTES = 147520;

__device__ __forceinline__ int lds_byte(int r, int c) {
  int st = (r >> 4) * 2 + (c >> 5), rr = r & 15, cc = c & 31, ob = rr * 64 + cc * 2;
  return st * 1024 + (ob ^ (((ob >> 9) & 1) << 5));
}
__device__ __forceinline__ void stage_rc(int b, int& R, int& C) {
  int st = b / 1024, sb = b % 1024, swz = sb ^ (((sb >> 9) & 1) << 5);
  R = (st >> 1) * 16 + swz / 64; C = (st & 1) * 32 + (swz % 64) / 2;
}

struct GemmDesc {
  const u16* A; const u16* Bt; int N, K, kind;
  EpiProj eproj; EpiLora elora; EpiResidB eresh; EpiResidB eresb; EpiRelu2 erelu;
};

__device__ __forceinline__ void gemm_phase(const Ctx c, const GemmDesc& gd, char* shm) {
  const u16* __restrict__ A = gd.A; const u16* __restrict__ Bt = gd.Bt;
  const int M = MTOK, N = gd.N, K = gd.K;
  constexpr int TILE_A = BM * BK * 2, TILE_B = BN * BK * 2, GLA = TILE_A / 8192, GLB = TILE_B / 8192, STAGE_B = TILE_A + TILE_B;
#define SA(b) (shm + (b) * STAGE_B)
#define SB(b) (shm + (b) * STAGE_B + TILE_A)
#define WAIT_V(n) asm volatile("s_waitcnt vmcnt(%0)" ::"n"(n) : "memory")
#define SCHED() __builtin_amdgcn_sched_barrier(0)
#define RAW_BARRIER() do { asm volatile("s_waitcnt lgkmcnt(0)" ::: "memory"); __builtin_amdgcn_s_barrier(); } while (0)
  const int nM = M / BM, nN = N / BN, nwg = nM * nN;
  const int tid = c.tid, wid = tid >> 6, lane = tid & 63, wr = wid >> 2, wc = wid & 3, fr = lane & 15, fq = lane >> 4;
  const int nt = K / BK;
  int sR[GLA], sC[GLA];
#pragma unroll
  for (int i = 0; i < GLA; ++i) stage_rc(wid * 1024 + i * 8192 + lane * 16, sR[i], sC[i]);
#define GLDS_STAGE(buf, kt, AP, BP) do { int Kl = K; asm volatile("" : "+s"(Kl)); \
    _Pragma("unroll") for (int i = 0; i < GLA; ++i) \
      __builtin_amdgcn_global_load_lds((const u32*)((AP) + (kt) * BK + (long)i * 64 * Kl), (u32*)(SA(buf) + wid * 1024 + i * 8192), 16, 0, 0); \
    _Pragma("unroll") for (int i = 0; i < GLB; ++i) \
      __builtin_amdgcn_global_load_lds((const u32*)((BP) + (kt) * BK + (long)i * 64 * Kl), (u32*)(SB(buf) + wid * 1024 + i * 8192), 16, 0, 0); } while (0)
#define KHALF(buf, ks, mh) do { bf16x8 At[4]; \
    _Pragma("unroll") for (int m = 0; m < 4; ++m) At[m] = *(const bf16x8*)(SA(buf) + lds_byte(wr * 128 + (mh) * 64 + m * 16 + fr, (ks) * 32 + fq * 8)); \
    _Pragma("unroll") for (int m = 0; m < 4; ++m) _Pragma("unroll") for (int n = 0; n < 4; ++n) \
      acc[(mh) * 4 + m][n] = __builtin_amdgcn_mfma_f32_16x16x32_bf16(Bf[n], At[m], acc[(mh) * 4 + m][n], 0, 0, 0); } while (0)
#define KSTEP(buf, ks) do { bf16x8 Bf[4]; \
    _Pragma("unroll") for (int n = 0; n < 4; ++n) Bf[n] = *(const bf16x8*)(SB(buf) + lds_byte(wc * 64 + n * 16 + fr, (ks) * 32 + fq * 8)); \
    KHALF(buf, ks, 0); KHALF(buf, ks, 1); } while (0)
#define COMPUTE(buf) do { KSTEP(buf, 0); KSTEP(buf, 1); } while (0)

  const int sRb = (sR[0] & ~31) + 8 * ((sR[0] & 15) >> 2) + (sR[0] & 3) + ((sR[0] & 16) ? 4 : 0);
#define TILE_COORDS(wg_, brow_, bcol_) do { int wgid = (wg_); \
    { int q = nwg / NXCD, r = nwg % NXCD, xcd = wgid % NXCD, off = wgid / NXCD; \
      wgid = (xcd < r ? xcd * (q + 1) : r * (q + 1) + (xcd - r) * q) + off; } \
    int nig = WGM * nN, gid = wgid / nig, fm = gid * WGM, gsz = min(nM - fm, WGM); \
    int pm = fm + ((wgid % nig) % gsz), pn = (wgid % nig) / gsz; brow_ = pm * BM; bcol_ = pn * BN; } while (0)
  int wg0 = c.bid;
  bool have = wg0 < nwg;
  int brow = 0, bcol = 0;
  const u16* ap = A; const u16* bp = Bt;
  if (have) {
    TILE_COORDS(wg0, brow, bcol);
    ap = A + (long)brow * K + (long)sR[0] * K + sC[0];
    bp = Bt + (long)bcol * K + (long)sRb * K + sC[0];
    GLDS_STAGE(0, 0, ap, bp);
  }
  while (have) {
    f32x4 acc[8][4];
#pragma unroll
    for (int m = 0; m < 8; ++m)
#pragma unroll
      for (int n = 0; n < 4; ++n) acc[m][n] = f32x4{0.f, 0.f, 0.f, 0.f};
    const int wgn = wg0 + c.nb;
    const bool hn = wgn < nwg;
    int brn = 0, bcn = 0;
    const u16* apn = A; const u16* bpn = Bt;
    if (hn) {
      TILE_COORDS(wgn, brn, bcn);
      apn = A + (long)brn * K + (long)sR[0] * K + sC[0];
      bpn = Bt + (long)bcn * K + (long)sRb * K + sC[0];
    }
    WAIT_V(0); __syncthreads();
#pragma unroll 2
    for (int t = 0; t < nt; ++t) {
      int cur = t & 1;
      if (t + 1 < nt) GLDS_STAGE(cur ^ 1, t + 1, ap, bp);
      else if (hn) GLDS_STAGE(0, 0, apn, bpn);
      COMPUTE(cur);
      if (t + 1 < nt) { WAIT_V(0); __syncthreads(); }
    }
#define EPILOOP(EPI) \
    _Pragma("unroll") for (int m = 0; m < 8; ++m) \
    _Pragma("unroll") for (int n = 0; n < 4; n += 2) \
      EPI(brow + wr * 128 + m * 16 + fr, bcol + wc * 64 + n * 16 + fq * 8, acc[m][n], acc[m][n + 1]);
    if (gd.kind == 0) { EPILOOP(gd.eproj) }
    else if (gd.kind == 1) { EPILOOP(gd.elora) }
    else if (gd.kind == 2) { EPILOOP(gd.eresh) }
    else if (gd.kind == 4) { EPILOOP(gd.eresb) }
    else { EPILOOP(gd.erelu) }
#undef EPILOOP
    wg0 = wgn; have = hn; brow = brn; bcol = bcn; ap = apn; bp = bpn;
  }
#undef TILE_COORDS
#undef SA
#undef SB
#undef GLDS_STAGE
#undef KHALF
#undef KSTEP
#undef COMPUTE
}

__device__ void transpose_convert(const Ctx c, const float* __restrict__ src, u16* __restrict__ dst, int K, int N, int Npad, float* lds) {
  const int tid = c.tid;
  const int tk = K / 64, tn = Npad / 64, ntile = tk * tn;
  for (int t = c.bid; t < ntile; t += c.nb) {
    int k0 = (t % tk) * 64, n0 = (t / tk) * 64;
    __syncthreads();
#pragma unroll
    for (int i = 0; i < 8; ++i) {
      int kk = i * 8 + (tid >> 6), nn = tid & 63;
      float v = (n0 + nn < N) ? __builtin_nontemporal_load(src + (size_t)(k0 + kk) * N + n0 + nn) : 0.f;
      lds[kk * 65 + nn] = v;
    }
    __syncthreads();
#pragma unroll
    for (int i = 0; i < 8; ++i) {
      int nn = i * 8 + (tid >> 6), kk = tid & 63;
      dst[(size_t)(n0 + nn) * K + k0 + kk] = f2bf(lds[kk * 65 + nn]);
    }
  }
}

__device__ void convert_weights(const Ctx c, const PV& p, int l, char* shm) {
  float* lds = (float*)shm;
  transpose_convert(c, p.in(IWIN) + (size_t)l * 1024 * 3344, (u16*)(p.ws() + OFF_WIN), 1024, 3344, NPROJ, lds);
  transpose_convert(c, p.in(IWOUT) + (size_t)l * 1024 * 1024, (u16*)(p.ws() + OFF_WOUT), 1024, 1024, 1024, lds);
  transpose_convert(c, p.in(IWFC) + (size_t)l * 1024 * 4096, (u16*)(p.ws() + OFF_WFC), 1024, 4096, 4096, lds);
  transpose_convert(c, p.in(IWPROJ) + (size_t)l * 4096 * 1024, (u16*)(p.ws() + OFF_WPROJ), 4096, 1024, 1024, lds);
  u16* wl = (u16*)(p.ws() + OFF_WLORA);
  const float* wup = p.in(IWUP) + (size_t)l * 2 * 64 * 512;
  const float* aup = p.in(IAUP) + (size_t)l * 2 * 64 * 512;
  const float* gup = p.in(IGUP) + (size_t)l * 128 * 512;
  for (int idx = c.bid * 512 + c.tid; idx < 2560 * 256; idx += c.nb * 512) {
    int n = idx >> 8, k = idx & 255;
    float v = 0.f;
    if (n < 1024) { if (k < 64) { int d = n >> 9, c = n & 511; v = wup[((size_t)d * 64 + k) * 512 + c]; } }
    else if (n < 2048) { if (k >= 64 && k < 128) { int d = (n - 1024) >> 9, c = n & 511; v = aup[((size_t)d * 64 + (k - 64)) * 512 + c]; } }
    else { if (k >= 128) { int c = n - 2048; v = gup[(size_t)(k - 128) * 512 + c]; } }
    wl[idx] = f2bf(v);
  }
}

__device__ void ln_phase(const Ctx c, const float* __restrict__ src, const float* __restrict__ g, const float* __restrict__ b,
                         float* __restrict__ dstf, u16* __restrict__ dstb) {
  const int wave = c.tid >> 6, lane = c.tid & 63;
  float4 gg[4], bb[4];
#pragma unroll
  for (int i = 0; i < 4; ++i) { gg[i] = ((const float4*)g)[lane + 64 * i]; bb[i] = ((const float4*)b)[lane + 64 * i]; }
  int row = c.bid * 8 + wave;
  float4 v[4], nv[4];
  if (row < MTOK) {
#pragma unroll
    for (int i = 0; i < 4; ++i) v[i] = ldnt16f((const float4*)(src + (size_t)row * DM) + lane + 64 * i);
  }
  for (; row < MTOK; row += c.nb * 8) {
    const int nrow = row + c.nb * 8;
    if (nrow < MTOK) {
#pragma unroll
      for (int i = 0; i < 4; ++i) nv[i] = ldnt16f((const float4*)(src + (size_t)nrow * DM) + lane + 64 * i);
    }
    float sum = 0.f;
#pragma unroll
    for (int i = 0; i < 4; ++i) sum += v[i].x + v[i].y + v[i].z + v[i].w;
    float mean = wave_sum(sum) * (1.f / DM);
    float sq = 0.f;
#pragma unroll
    for (int i = 0; i < 4; ++i) {
      float a = v[i].x - mean, b2 = v[i].y - mean, c2 = v[i].z - mean, d = v[i].w - mean;
      sq += a * a + b2 * b2 + c2 * c2 + d * d;
    }
    float rstd = rsqrtf(wave_sum(sq) * (1.f / DM) + LN_EPS);
#pragma unroll
    for (int i = 0; i < 4; ++i) {
      float4 o;
      o.x = (v[i].x - mean) * rstd * gg[i].x + bb[i].x; o.y = (v[i].y - mean) * rstd * gg[i].y + bb[i].y;
      o.z = (v[i].z - mean) * rstd * gg[i].z + bb[i].z; o.w = (v[i].w - mean) * rstd * gg[i].w + bb[i].w;
      uint2 pk; pk.x = pack2(o.x, o.y); pk.y = pack2(o.z, o.w);
      ((uint2*)((u16*)dstf + (size_t)row * DM))[lane + 64 * i] = pk;
      ((uint2*)(dstb + (size_t)row * DM))[lane + 64 * i] = pk;
    }
#pragma unroll
    for (int i = 0; i < 4; ++i) v[i] = nv[i];
  }
}

__device__ __forceinline__ void unpack8(const uint4& v, float (&f)[8]) {
  f[0] = bflo(v.x); f[1] = bfhi(v.x); f[2] = bflo(v.y); f[3] = bfhi(v.y);
  f[4] = bflo(v.z); f[5] = bfhi(v.z); f[6] = bflo(v.w); f[7] = bfhi(v.w);
}
__device__ __forceinline__ uint4 pack8(const float (&f)[8]) {
  uint4 o; o.x = pack2(f[0], f[1]); o.y = pack2(f[2], f[3]); o.z = pack2(f[4], f[5]); o.w = pack2(f[6], f[7]);
  return o;
}

constexpr int LNG = 4;
__device__ void ln_phase_b(const Ctx c, const u16* __restrict__ src, const float* __restrict__ g, const float* __restrict__ b,
                           float* __restrict__ dstf, u16* __restrict__ dstb, bool write_f, bool write_b, bool write_h) {
  const int wave = c.tid >> 6, lane = c.tid & 63;
  float gg[16], bb[16];
#pragma unroll
  for (int i = 0; i < 2; ++i)
#pragma unroll
    for (int e = 0; e < 8; ++e) { gg[8 * i + e] = g[8 * (lane + 64 * i) + e]; bb[8 * i + e] = b[8 * (lane + 64 * i) + e]; }
  const int stride = c.nb * 8;
  int row0 = c.bid * 8 + wave;
  uint4 v[LNG][2], nv[LNG][2];
#define LN_LOAD(D, r0) do { _Pragma("unroll") for (int q = 0; q < LNG; ++q) { const int rr_ = (r0) + q * stride; \
      if (rr_ < MTOK) { D[q][0] = ldnt16((const uint4*)(src + (size_t)rr_ * DM) + lane); D[q][1] = ldnt16((const uint4*)(src + (size_t)rr_ * DM) + lane + 64); } } } while (0)
  LN_LOAD(v, row0);
  for (; row0 < MTOK; row0 += LNG * stride) {
    const int nrow0 = row0 + LNG * stride;
    if (nrow0 < MTOK) LN_LOAD(nv, nrow0);
#pragma unroll
    for (int q = 0; q < LNG; ++q) {
      const int row = row0 + q * stride;
      if (row < MTOK) {
        float x[16];
        { float t0[8], t1[8]; unpack8(v[q][0], t0); unpack8(v[q][1], t1);
#pragma unroll
          for (int e = 0; e < 8; ++e) { x[e] = t0[e]; x[8 + e] = t1[e]; } }
        float sum = 0.f;
#pragma unroll
        for (int e = 0; e < 16; ++e) sum += x[e];
        const float mean = wave_sum(sum) * (1.f / DM);
        float sq = 0.f;
#pragma unroll
        for (int e = 0; e < 16; ++e) { float dlt = x[e] - mean; sq += dlt * dlt; }
        const float rstd = rsqrtf(wave_sum(sq) * (1.f / DM) + LN_EPS);
#pragma unroll
        for (int i = 0; i < 2; ++i) {
          float o[8];
#pragma unroll
          for (int e = 0; e < 8; ++e) o[e] = (x[8 * i + e] - mean) * rstd * gg[8 * i + e] + bb[8 * i + e];
          if (write_f) {
            float4* d = (float4*)(dstf + (size_t)row * DM + 8 * (lane + 64 * i));
            d[0] = make_float4(o[0], o[1], o[2], o[3]); d[1] = make_float4(o[4], o[5], o[6], o[7]);
          }
          if (write_b) ((uint4*)(dstb + (size_t)row * DM))[lane + 64 * i] = pack8(o);
          if (write_h) ((uint4*)((u16*)dstf + (size_t)row * DM))[lane + 64 * i] = pack8(o);
        }
      }
    }
#pragma unroll
    for (int q = 0; q < LNG; ++q) { v[q][0] = nv[q][0]; v[q][1] = nv[q][1]; }
  }
#undef LN_LOAD
}

constexpr int PT = 32, PB = 8;
__device__ __forceinline__ void prep_conv(const PV& p, int l, int tile, int cg) {
  const u16* proj = (const u16*)(p.ws() + OFF_P);
  const uint4 zero4 = make_uint4(0u, 0u, 0u, 0u);
  const int t0 = tile * PT, ts0 = t0 & (SEQ - 1);
  {
      const int c0 = cg * 8;
      const float* cw = p.in(ICONVW) + (size_t)l * 5 * 1024 + c0;
      const float* cb = p.in(ICONVB) + (size_t)l * 1024 + c0;
      float w[5][8], bias[8];
#pragma unroll
      for (int j = 0; j < 5; ++j)
#pragma unroll
        for (int e = 0; e < 8; ++e) w[j][e] = cw[j * 1024 + e];
#pragma unroll
      for (int e = 0; e < 8; ++e) bias[e] = cb[e];
      u16* dst; int dstride;
      if (c0 < 512) { dst = (u16*)(p.ws() + OFF_XS) + c0; dstride = 512; }
      else if (c0 < 768) { dst = (u16*)(p.ws() + OFF_BM) + (c0 - 512); dstride = 256; }
      else { dst = (u16*)(p.ws() + OFF_CM) + (c0 - 768); dstride = 256; }
      const u16* src = proj + (size_t)t0 * NPROJ + 512 + c0;
      uint4 x0, x1, x2, x3;
      x0 = (ts0 >= 2) ? ldnt16(src - 2 * (long)NPROJ) : zero4;
      x1 = (ts0 >= 1) ? ldnt16(src - (long)NPROJ) : zero4;
      x2 = ldnt16(src);
      x3 = ldnt16(src + NPROJ);
      uint4 cur[PB], nxt[PB];
#pragma unroll
      for (int u = 0; u < PB; ++u) cur[u] = (ts0 + u + 2 < SEQ) ? ldnt16(src + (long)(u + 2) * NPROJ) : zero4;
      for (int tb = 0; tb < PT; tb += PB) {
        if (tb + PB < PT) {
#pragma unroll
          for (int u = 0; u < PB; ++u) nxt[u] = (ts0 + tb + PB + u + 2 < SEQ) ? ldnt16(src + (long)(tb + PB + u + 2) * NPROJ) : zero4;
        }
#pragma unroll
        for (int u = 0; u < PB; ++u) {
          const uint4 x4 = cur[u];
          float f0[8], f1[8], f2[8], f3[8], f4[8], o[8];
          unpack8(x0, f0); unpack8(x1, f1); unpack8(x2, f2); unpack8(x3, f3); unpack8(x4, f4);
#pragma unroll
          for (int e = 0; e < 8; ++e) {
            float a = bias[e] + w[0][e] * f0[e] + w[1][e] * f1[e] + w[2][e] * f2[e] + w[3][e] * f3[e] + w[4][e] * f4[e];
            o[e] = siluf_(a);
          }
          *(uint4*)(dst + (size_t)(t0 + tb + u) * dstride) = pack8(o);
          x0 = x1; x1 = x2; x2 = x3; x3 = x4;
        }
#pragma unroll
        for (int u = 0; u < PB; ++u) cur[u] = nxt[u];
      }
  }
}

__device__ __forceinline__ void prep_rw(const PV& p, int l, int tile, int rg) {
  const u16* proj = (const u16*)(p.ws() + OFF_P);
  const uint4 zero4 = make_uint4(0u, 0u, 0u, 0u);
  const int t0 = tile * PT, ts0 = t0 & (SEQ - 1);
  {
      const int c0 = rg * 8;
      const float* mup = p.in(IMU) + (size_t)l * 1792 + c0;
      float mu[8], kkc[8];
#pragma unroll
      for (int e = 0; e < 8; ++e) mu[e] = mup[e];
      const bool isk = (rg >= 64 && rg < 128);
      if (isk) {
#pragma unroll
        for (int e = 0; e < 8; ++e) kkc[e] = p.in(IKK)[(size_t)l * 512 + (c0 - 512) + e];
      } else {
#pragma unroll
        for (int e = 0; e < 8; ++e) kkc[e] = 0.f;
      }
      u16* dst; int dstride;
      if (rg < 64) { dst = (u16*)(p.ws() + OFF_R) + c0; dstride = 512; }
      else if (rg < 128) { dst = (u16*)(p.ws() + OFF_K) + (c0 - 512); dstride = 512; }
      else if (rg < 192) { dst = (u16*)(p.ws() + OFF_V) + (c0 - 1024); dstride = 512; }
      else { dst = (u16*)(p.ws() + OFF_S) + (c0 - 1536); dstride = 256; }
      float* invn = (float*)(p.ws() + OFF_INVN);
      const u16* src = proj + (size_t)t0 * NPROJ + SSD_COLS + c0;
      uint4 xm, x0;
      xm = (ts0 >= 1) ? ldnt16(src - (long)NPROJ) : zero4;
      x0 = ldnt16(src);
      uint4 cur[PB], nxt[PB];
#pragma unroll
      for (int u = 0; u < PB; ++u) cur[u] = (ts0 + u + 1 < SEQ) ? ldnt16(src + (long)(u + 1) * NPROJ) : zero4;
      for (int tb = 0; tb < PT; tb += PB) {
        if (tb + PB < PT) {
#pragma unroll
          for (int u = 0; u < PB; ++u) nxt[u] = (ts0 + tb + PB + u + 1 < SEQ) ? ldnt16(src + (long)(tb + PB + u + 1) * NPROJ) : zero4;
        }
#pragma unroll
        for (int u = 0; u < PB; ++u) {
          const uint4 xp = cur[u];
          const int t = tb + u;
          float fm[8], f0[8], fp[8], o[8];
          unpack8(xm, fm); unpack8(x0, f0); unpack8(xp, fp);
#pragma unroll
          for (int e = 0; e < 8; ++e) o[e] = f0[e] + (0.5f * (fm[e] + fp[e]) - f0[e]) * mu[e];
          if (rg >= 192) {
            if (rg < 200) {
#pragma unroll
              for (int e = 0; e < 8; ++e) o[e] = tanhf_(o[e]);
            } else if (rg >= 208) {
#pragma unroll
              for (int e = 0; e < 8; ++e) o[e] = sigmoidf_(o[e]);
            }
          }
          const uint4 ov = pack8(o);
          *(uint4*)(dst + (size_t)(t0 + t) * dstride) = ov;
          if (isk) {
            float kr[8]; unpack8(ov, kr);
            float ss = 0.f;
#pragma unroll
            for (int e = 0; e < 8; ++e) { float qv = kr[e] * kkc[e]; ss += qv * qv; }
            ss += __shfl_xor(ss, 1); ss += __shfl_xor(ss, 2); ss += __shfl_xor(ss, 4);
            if ((rg & 7) == 0) invn[(size_t)(t0 + t) * 8 + ((rg - 64) >> 3)] = 1.f / fmaxf(sqrtf(ss), 1e-12f);
          }
          xm = x0; x0 = xp;
        }
#pragma unroll
        for (int u = 0; u < PB; ++u) cur[u] = nxt[u];
      }
  }
}

__device__ __forceinline__ void prep_z(const PV& p, int l, int tile, int zg) {
  const u16* proj = (const u16*)(p.ws() + OFF_P);
  const uint4 zero4 = make_uint4(0u, 0u, 0u, 0u);
  const int t0 = tile * PT, ts0 = t0 & (SEQ - 1);
  {
      const int c0 = zg * 8;
      const u16* src = proj + (size_t)t0 * NPROJ + c0;
      u16* dst = (u16*)(p.ws() + OFF_SZ) + c0;
      for (int tb = 0; tb < PT; tb += PB) {
        uint4 xx[PB];
#pragma unroll
        for (int u = 0; u < PB; ++u) xx[u] = ldnt16(src + (long)(tb + u) * NPROJ);
#pragma unroll
        for (int u = 0; u < PB; ++u) {
          float f[8], o[8]; unpack8(xx[u], f);
#pragma unroll
          for (int e = 0; e < 8; ++e) o[e] = siluf_(f[e]);
          *(uint4*)(dst + (size_t)(t0 + tb + u) * 512) = pack8(o);
        }
      }
  }
}

__device__ void prep_phase(const Ctx c, const PV& p, int l) {
  const int tid = c.tid;
  constexpr int NT = MTOK / PT;
  for (int g = c.bid; g < NT / 4; g += c.nb) prep_conv(p, l, g * 4 + (tid >> 7), tid & 127);
  for (int g = c.bid; g < NT / 2; g += c.nb) { const int rg = tid & 255; if (rg < 224) prep_rw(p, l, g * 2 + (tid >> 8), rg); }
  for (int g = c.bid; g < NT / 8; g += c.nb) prep_z(p, l, g * 8 + (tid >> 6), tid & 63);
  {
    const float* dtraw = (const float*)(p.ws() + OFF_DTRAW);
    float* dt = (float*)(p.ws() + OFF_DT);
    float xv[4];
#pragma unroll
    for (int u = 0; u < 4; ++u) xv[u] = dtraw[(size_t)(u * c.nb + c.bid) * 512 + tid];
    const float bia = p.in(IDTB)[(size_t)l * 16 + (tid & 15)];
#pragma unroll
    for (int u = 0; u < 4; ++u) dt[(size_t)(u * c.nb + c.bid) * 512 + tid] = softplusf_(xv[u] + bia);
  }
}

__device__ __forceinline__ float rowsum4(float x) {
  auto r = __builtin_amdgcn_permlane16_swap(__float_as_uint(x), __float_as_uint(x), false, false);
  float y = __uint_as_float(r[0]) + __uint_as_float(r[1]);
  auto r2 = __builtin_amdgcn_permlane32_swap(__float_as_uint(y), __float_as_uint(y), false, false);
  return __uint_as_float(r2[0]) + __uint_as_float(r2[1]);
}

#define DPPB(I) " row_newbcast:" #I " row_mask:0xf bank_mask:0xf\n"

__device__ __forceinline__ float dot16(const float (&S)[16], float vec) {
  float acc;
  asm volatile("s_nop 1\n"
      "v_mul_f32_dpp %0, %17, %1" DPPB(0)
      "v_fmac_f32_dpp %0, %17, %2" DPPB(1)
      "v_fmac_f32_dpp %0, %17, %3" DPPB(2)
      "v_fmac_f32_dpp %0, %17, %4" DPPB(3)
      "v_fmac_f32_dpp %0, %17, %5" DPPB(4)
      "v_fmac_f32_dpp %0, %17, %6" DPPB(5)
      "v_fmac_f32_dpp %0, %17, %7" DPPB(6)
      "v_fmac_f32_dpp %0, %17, %8" DPPB(7)
      "v_fmac_f32_dpp %0, %17, %9" DPPB(8)
      "v_fmac_f32_dpp %0, %17, %10" DPPB(9)
      "v_fmac_f32_dpp %0, %17, %11" DPPB(10)
      "v_fmac_f32_dpp %0, %17, %12" DPPB(11)
      "v_fmac_f32_dpp %0, %17, %13" DPPB(12)
      "v_fmac_f32_dpp %0, %17, %14" DPPB(13)
      "v_fmac_f32_dpp %0, %17, %15" DPPB(14)
      "v_fmac_f32_dpp %0, %17, %16" DPPB(15)
      : "=&v"(acc)
      : "v"(S[0]), "v"(S[1]), "v"(S[2]), "v"(S[3]), "v"(S[4]), "v"(S[5]), "v"(S[6]), "v"(S[7]),
        "v"(S[8]), "v"(S[9]), "v"(S[10]), "v"(S[11]), "v"(S[12]), "v"(S[13]), "v"(S[14]), "v"(S[15]), "v"(vec));
  return acc;
}

#define UPD(I, SI) \
      "v_mul_f32_dpp " SI ", %16, " SI DPPB(I) \
      "v_fmac_f32_dpp " SI ", %17, %19" DPPB(I) \
      "v_fmac_f32_dpp " SI ", %18, %20" DPPB(I)
__device__ __forceinline__ void update16(float (&S)[16], float w, float b, float kd, float nskk, float vv) {
  asm volatile("s_nop 1\n"
      UPD(0, "%0") UPD(1, "%1") UPD(2, "%2") UPD(3, "%3") UPD(4, "%4") UPD(5, "%5") UPD(6, "%6") UPD(7, "%7")
      UPD(8, "%8") UPD(9, "%9") UPD(10, "%10") UPD(11, "%11") UPD(12, "%12") UPD(13, "%13") UPD(14, "%14") UPD(15, "%15")
      : "+v"(S[0]), "+v"(S[1]), "+v"(S[2]), "+v"(S[3]), "+v"(S[4]), "+v"(S[5]), "+v"(S[6]), "+v"(S[7]),
        "+v"(S[8]), "+v"(S[9]), "+v"(S[10]), "+v"(S[11]), "+v"(S[12]), "+v"(S[13]), "+v"(S[14]), "+v"(S[15])
      : "v"(w), "v"(b), "v"(kd), "v"(nskk), "v"(vv));
}

typedef float f32x2 __attribute__((ext_vector_type(2)));
constexpr int RB = 16;
constexpr int RW_STEP = 1536;
constexpr int RW_OFF = 90112;
constexpr int RW_CNT = RW_OFF + 2 * RB * RW_STEP;
constexpr int RW_YBUF = 139520;
constexpr int XB_LDS_OFF = 147456;

__device__ __forceinline__ void group_barrier(int* cnt, int& gen, int lane);

__device__ void rwkv_scan(const PV& p, int l, int item, int tid  , char* shm, int& gen) {
  const int d = item >> 7, b = (item >> 3) & 15, h = item & 7;
  const int j = tid >> 6, lane = tid & 63, vl = lane & 15, q = lane >> 4;
  const u16* rr = (const u16*)(p.ws() + OFF_R); const u16* kk_ = (const u16*)(p.ws() + OFF_K); const u16* vv_ = (const u16*)(p.ws() + OFF_V);
  const u16* ee = (const u16*)(p.ws() + OFF_E) + (size_t)d * MTOK * 512;
  const u16* aa = (const u16*)(p.ws() + OFF_A) + (size_t)d * MTOK * 512;
  const float* invn = (const float*)(p.ws() + OFF_INVN);
  u16* yr = (u16*)(p.ws() + OFF_YR) + (size_t)d * MTOK * 512;
  int* cnt = (int*)(shm + RW_CNT);
  const int ch = h * 64 + lane, chv = h * 64 + 16 * j + vl;
  const float kkc = p.in(IKK)[(size_t)l * 512 + ch];
  const float ka = p.in(IKA)[(size_t)l * 512 + ch];
  const long tok0 = (long)b * SEQ + (d ? SEQ - 1 : 0);
  const long dstep = d ? -1 : 1;

  u16 gr[4], gk[4], ge[4], ga[4], gv[4]; float gi[4];
#define RW_LOAD(n) do { _Pragma("unroll") for (int s = 0; s < 4; ++s) { \
      long tok = tok0 + dstep * ((n) * RB + 4 * j + s); \
      gr[s] = rr[tok * 512 + ch]; gk[s] = kk_[tok * 512 + ch]; ge[s] = __builtin_nontemporal_load(ee + tok * 512 + ch); ga[s] = __builtin_nontemporal_load(aa + tok * 512 + ch); \
      gv[s] = vv_[tok * 512 + ch]; gi[s] = invn[tok * 8 + h]; } } while (0)
#define RW_WRITE(n) do { _Pragma("unroll") for (int s = 0; s < 4; ++s) { \
      float* dst = (float*)(shm + RW_OFF + ((n) & 1) * RB * RW_STEP + (4 * j + s) * RW_STEP); \
      float r = bf2f(gr[s]), k = bf2f(gk[s]), e = bf2f(ge[s]), a = bf2f(ga[s]); \
      float kkv = k * kkc * gi[s]; \
      dst[lane] = kkv; dst[64 + lane] = __expf(-e); dst[128 + lane] = kkv * a; \
      dst[192 + lane] = k * (1.f + (a - 1.f) * ka); dst[256 + lane] = r; dst[320 + lane] = bf2f(gv[s]); } } while (0)

  const int q8 = lane >> 3, rp = lane & 7;
  float S0[8], S1[8];
#pragma unroll
  for (int i = 0; i < 8; ++i) { S0[i] = 0.f; S1[i] = 0.f; }
#define FMAC(acc, a, b) acc = __builtin_fmaf(a, b, acc)
#define FMUL(dst, a, b) dst = (a) * (b)
#define REDUCE2(x0, x1, t0, t1) do { \
    float _a = x0 + __builtin_bit_cast(float, __builtin_amdgcn_update_dpp(0, __builtin_bit_cast(int, x0), 0x128, 0xf, 0xf, false)); \
    float _b = x1 + __builtin_bit_cast(float, __builtin_amdgcn_update_dpp(0, __builtin_bit_cast(int, x1), 0x128, 0xf, 0xf, false)); \
    auto _r = __builtin_amdgcn_permlane16_swap(__float_as_uint(_a), __float_as_uint(_b), false, false); \
    float _c = __uint_as_float(_r[0]) + __uint_as_float(_r[1]); \
    auto _r2 = __builtin_amdgcn_permlane32_swap(__float_as_uint(_c), __float_as_uint(_c), false, false); \
    float _d = __uint_as_float(_r2[0]) + __uint_as_float(_r2[1]); \
    auto _r3 = __builtin_amdgcn_permlane16_swap(__float_as_uint(_d), __float_as_uint(_d), false, false); \
    t0 = __uint_as_float(_r3[0]); t1 = __uint_as_float(_r3[1]); } while (0)
  u32* ybuf = (u32*)(shm + RW_YBUF) + j * (RB * 8);
  RW_LOAD(0); RW_WRITE(0);
  group_barrier(cnt, gen, lane);
  for (int n = 0; n < SEQ / RB; ++n) {
    if (n + 1 < SEQ / RB) RW_LOAD(n + 1);
    int boff = RW_OFF + (n & 1) * RB * RW_STEP + q8 * 32;
    asm volatile("" : "+v"(boff));
    const char* bufb = shm + boff;
    const int voff = 1280 - q8 * 32 + (16 * j + 2 * rp) * 4;
    f32x4 k4[2]; f32x2 vv;
    k4[0] = ((const f32x4*)bufb)[0]; k4[1] = ((const f32x4*)bufb)[1];
    vv = *(const f32x2*)(bufb + voff);
#pragma unroll
    for (int s = 0; s < RB; ++s) {
      const f32x4* P = (const f32x4*)(bufb + s * RW_STEP);
      f32x4 w4[2], b4[2], d4[2], r4[2];
#pragma unroll
      for (int i = 0; i < 2; ++i) { w4[i] = P[16 + i]; b4[i] = P[32 + i]; d4[i] = P[48 + i]; r4[i] = P[64 + i]; }
      float a0, a1;
      FMUL(a0, S0[0], k4[0][0]); FMUL(a1, S1[0], k4[0][0]);
#pragma unroll
      for (int i = 1; i < 8; ++i) { FMAC(a0, S0[i], k4[i >> 2][i & 3]); FMAC(a1, S1[i], k4[i >> 2][i & 3]); }
      float t0, t1;
      REDUCE2(a0, a1, t0, t1);
      const float ns0 = -t0, ns1 = -t1;
      const float v0 = vv[0], v1 = vv[1];
      if (s + 1 < RB) {
        k4[0] = ((const f32x4*)(bufb + (s + 1) * RW_STEP))[0]; k4[1] = ((const f32x4*)(bufb + (s + 1) * RW_STEP))[1];
        vv = *(const f32x2*)(bufb + (s + 1) * RW_STEP + voff);
      }
#pragma unroll
      for (int i = 0; i < 8; ++i) {
        FMUL(S0[i], S0[i], w4[i >> 2][i & 3]); FMUL(S1[i], S1[i], w4[i >> 2][i & 3]);
        FMAC(S0[i], ns0, b4[i >> 2][i & 3]);   FMAC(S1[i], ns1, b4[i >> 2][i & 3]);
        FMAC(S0[i], v0, d4[i >> 2][i & 3]);    FMAC(S1[i], v1, d4[i >> 2][i & 3]);
      }
      float y0, y1;
      FMUL(y0, S0[0], r4[0][0]); FMUL(y1, S1[0], r4[0][0]);
#pragma unroll
      for (int i = 1; i < 8; ++i) { FMAC(y0, S0[i], r4[i >> 2][i & 3]); FMAC(y1, S1[i], r4[i >> 2][i & 3]); }
      float yt0, yt1;
      REDUCE2(y0, y1, yt0, yt1);
      ybuf[s * 8 + rp] = pack2(yt0, yt1);
    }
    asm volatile("s_waitcnt lgkmcnt(0)" ::: "memory");
#pragma unroll
    for (int u = 0; u < 2; ++u) {
      const int s = (lane >> 3) + 8 * u;
      *(u32*)(yr + (tok0 + dstep * (n * RB + s)) * 512 + h * 64 + 16 * j + 2 * rp) = ybuf[s * 8 + rp];
    }
    if (n + 1 < SEQ / RB) RW_WRITE(n + 1);
    group_barrier(cnt, gen, lane);
  }
#undef REDUCE2
#undef FMAC
#undef FMUL
#undef RW_LOAD
#undef RW_WRITE
}

__device__ __forceinline__ void group_barrier(int* cnt, int& gen, int lane) {
  __builtin_amdgcn_fence(__ATOMIC_RELEASE, "workgroup");
  gen += 4;
  if (lane == 0) __hip_atomic_fetch_add(cnt, 1, __ATOMIC_RELAXED, __HIP_MEMORY_SCOPE_WORKGROUP);
  while (__hip_atomic_load(cnt, __ATOMIC_RELAXED, __HIP_MEMORY_SCOPE_WORKGROUP) < gen) __builtin_amdgcn_s_sleep(1);
  __builtin_amdgcn_fence(__ATOMIC_ACQUIRE, "workgroup");
}

constexpr int LC = 64;
constexpr int ST128 = 136, ST64 = 72;
constexpr int SSD_SC = 0, SSD_SB = 17408, SSD_SBT = 34816, SSD_SXT = 53248, SSD_SM = 62464, SSD_SH = 71680, SSD_CNT = 89088;

__device__ void ssd_item(const PV& p, int l, int item, int tid  , char* shm, int& gen) {
  const int d = item >> 7, b = (item >> 3) & 15, h = item & 7, g = h >> 2;
  const int w4 = tid >> 6, lane = tid & 63, wr = w4 >> 1, wc = w4 & 1, l31 = lane & 31, hi = lane >> 5;
  u16* sC = (u16*)(shm + SSD_SC); u16* sB = (u16*)(shm + SSD_SB); u16* sBT = (u16*)(shm + SSD_SBT);
  u16* sXT = (u16*)(shm + SSD_SXT); u16* sM = (u16*)(shm + SSD_SM); u16* sH = (u16*)(shm + SSD_SH);
  int* cnt = (int*)(shm + SSD_CNT);
  const u16* xs = (const u16*)(p.ws() + OFF_XS); const u16* Bm = (const u16*)(p.ws() + OFF_BM); const u16* Cm = (const u16*)(p.ws() + OFF_CM);
  const float* dt = (const float*)(p.ws() + OFF_DT);
  u16* ys = (u16*)(p.ws() + OFF_S) + (size_t)d * MTOK * 512;
  const float Aneg = -__expf(p.in(IALOG)[l * 16 + d * 8 + h]);
  for (int i = tid; i < 64 * ST128 / 2; i += 256) ((u32*)sH)[i] = 0u;
  f32x16 Hacc[2];
#pragma unroll
  for (int i = 0; i < 16; ++i) { Hacc[0][i] = 0.f; Hacc[1][i] = 0.f; }

  for (int ci = 0; ci < SEQ / LC; ++ci) {
    const int c = d ? (SEQ / LC - 1 - ci) : ci;
    const long tokbase = (long)b * SEQ + c * LC;
#define TOK(lr) (tokbase + (d ? (LC - 1 - (lr)) : (lr)))
    const float dtv = dt[TOK(lane) * 16 + d * 8 + h];
    float cs = dtv * Aneg;
#pragma unroll
    for (int o = 1; o < 64; o <<= 1) { float t = __shfl_up(cs, o); if (lane >= o) cs += t; }
    const float cs_last = __shfl(cs, 63);
#pragma unroll
    for (int i = 0; i < 4; ++i) {
      int idx = tid + 256 * i, row = idx & 63, seg = idx >> 6;
      long tk = TOK(row);
      uint4 cvv = *(const uint4*)(Cm + tk * 256 + g * 128 + seg * 8);
      uint4 bvv = *(const uint4*)(Bm + tk * 256 + g * 128 + seg * 8);
      *(uint4*)(sC + row * ST128 + seg * 8) = cvv;
      *(uint4*)(sB + row * ST128 + seg * 8) = bvv;
      float dec = __expf(cs_last - cs);
      u32 bw[4] = {bvv.x, bvv.y, bvv.z, bvv.w};
#pragma unroll
      for (int q = 0; q < 4; ++q) {
        sBT[(seg * 8 + 2 * q) * ST64 + row] = f2bf(bflo(bw[q]) * dec);
        sBT[(seg * 8 + 2 * q + 1) * ST64 + row] = f2bf(bfhi(bw[q]) * dec);
      }
    }
#pragma unroll
    for (int i = 0; i < 2; ++i) {
      int idx = tid + 256 * i, row = idx & 63, seg = idx >> 6;
      long tk = TOK(row);
      uint4 xv = *(const uint4*)(xs + tk * 512 + h * 64 + seg * 8);
      float dts = dtv;
      u32 xw[4] = {xv.x, xv.y, xv.z, xv.w};
#pragma unroll
      for (int q = 0; q < 4; ++q) {
        sXT[(seg * 8 + 2 * q) * ST64 + row] = f2bf(bflo(xw[q]) * dts);
        sXT[(seg * 8 + 2 * q + 1) * ST64 + row] = f2bf(bfhi(xw[q]) * dts);
      }
    }
    group_barrier(cnt, gen, lane);
    {
      f32x16 acc;
#pragma unroll
      for (int i = 0; i < 16; ++i) acc[i] = 0.f;
#pragma unroll
      for (int kb = 0; kb < 8; ++kb) {
        bf16x8 a = *(const bf16x8*)(sC + (32 * wr + l31) * ST128 + kb * 16 + hi * 8);
        bf16x8 bb = *(const bf16x8*)(sB + (32 * wc + l31) * ST128 + kb * 16 + hi * 8);
        acc = __builtin_amdgcn_mfma_f32_32x32x16_bf16(a, bb, acc, 0, 0, 0);
      }
      const int s = 32 * wc + l31;
      const float cs_s = __shfl(cs, s);
#pragma unroll
      for (int i = 0; i < 16; ++i) {
        int lrow = 32 * wr + 8 * (i >> 2) + 4 * hi + (i & 3);
        const int lr0 = 32 * wr + 8 * (i >> 2) + (i & 3);
        float cs_l = __uint_as_float(hi ? __builtin_amdgcn_readlane(__float_as_uint(cs), lr0 + 4) : __builtin_amdgcn_readlane(__float_as_uint(cs), lr0));
        float m = (s <= lrow) ? acc[i] * __expf(cs_l - cs_s) : 0.f;
        sM[lrow * ST64 + s] = f2bf(m);
      }
    }
    group_barrier(cnt, gen, lane);
    {
      f32x16 acc1, acc2;
#pragma unroll
      for (int i = 0; i < 16; ++i) { acc1[i] = 0.f; acc2[i] = 0.f; }
#pragma unroll
      for (int kb = 0; kb < 4; ++kb) {
        bf16x8 a = *(const bf16x8*)(sM + (32 * wr + l31) * ST64 + kb * 16 + hi * 8);
        bf16x8 bb = *(const bf16x8*)(sXT + (32 * wc + l31) * ST64 + kb * 16 + hi * 8);
        acc1 = __builtin_amdgcn_mfma_f32_32x32x16_bf16(a, bb, acc1, 0, 0, 0);
      }
#pragma unroll
      for (int kb = 0; kb < 8; ++kb) {
        bf16x8 a = *(const bf16x8*)(sC + (32 * wr + l31) * ST128 + kb * 16 + hi * 8);
        bf16x8 bb = *(const bf16x8*)(sH + (32 * wc + l31) * ST128 + kb * 16 + hi * 8);
        acc2 = __builtin_amdgcn_mfma_f32_32x32x16_bf16(a, bb, acc2, 0, 0, 0);
      }
      const int pcol = h * 64 + 32 * wc + l31;
#pragma unroll
      for (int i = 0; i < 16; ++i) {
        int lrow = 32 * wr + 8 * (i >> 2) + 4 * hi + (i & 3);
        const int lr0 = 32 * wr + 8 * (i >> 2) + (i & 3);
        const float cs_l = __uint_as_float(hi ? __builtin_amdgcn_readlane(__float_as_uint(cs), lr0 + 4) : __builtin_amdgcn_readlane(__float_as_uint(cs), lr0));
        float y = acc1[i] + __expf(cs_l) * acc2[i];
        ys[TOK(lrow) * 512 + pcol] = f2bf(y);
      }
    }
    group_barrier(cnt, gen, lane);
    {
      const float dall = __expf(cs_last);
#pragma unroll
      for (int nt = 0; nt < 2; ++nt) {
#pragma unroll
        for (int i = 0; i < 16; ++i) Hacc[nt][i] *= dall;
#pragma unroll
        for (int kb = 0; kb < 4; ++kb) {
          bf16x8 a = *(const bf16x8*)(sXT + (32 * wr + l31) * ST64 + kb * 16 + hi * 8);
          bf16x8 bb = *(const bf16x8*)(sBT + (64 * wc + 32 * nt + l31) * ST64 + kb * 16 + hi * 8);
          Hacc[nt] = __builtin_amdgcn_mfma_f32_32x32x16_bf16(a, bb, Hacc[nt], 0, 0, 0);
        }
#pragma unroll
        for (int i = 0; i < 16; ++i) {
          int prow = 32 * wr + 8 * (i >> 2) + 4 * hi + (i & 3);
          sH[prow * ST128 + 64 * wc + 32 * nt + l31] = f2bf(Hacc[nt][i]);
        }
      }
    }
    group_barrier(cnt, gen, lane);
#undef TOK
  }
}

__device__ void mixer_phase(const Ctx c, const PV& p, int l, char* shm) {
  int* cnt = (int*)(shm + SSD_CNT);
  int* cnt2 = (int*)(shm + RW_CNT);
  if (c.tid == 0) { *cnt = 0; *cnt2 = 0; }
  __syncthreads();
  int gen = 0;
  if (c.tid < 256) {
    for (int rep = 0; rep < ((PROBE_MIX & 1) ? 2 : 1); ++rep)
    for (int it = c.bid; it < 256; it += c.nb) rwkv_scan(p, l, it, c.tid, shm, gen);
  } else {
    for (int rep = 0; rep < ((PROBE_MIX & 2) ? 2 : 1); ++rep)
    for (int it = c.bid; it < 256; it += c.nb) ssd_item(p, l, it, c.tid - 256, shm, gen);
  }
}

__device__ void post_phase(const Ctx c, const PV& p, int l) {
  const int wave = c.tid >> 6, lane = c.tid & 63;
  const u16* xs = (const u16*)(p.ws() + OFF_XS); const u16* sz = (const u16*)(p.ws() + OFF_SZ);
  const u16* ys = (const u16*)(p.ws() + OFF_S);
  const u16* yr = (const u16*)(p.ws() + OFF_YR);
  const u16* rr = (const u16*)(p.ws() + OFF_R); const u16* kk_ = (const u16*)(p.ws() + OFF_K); const u16* vv = (const u16*)(p.ws() + OFF_V);
  const u16* aa = (const u16*)(p.ws() + OFF_A); const u16* gg = (const u16*)(p.ws() + OFF_G);
  u16* ymix = (u16*)(p.ws() + OFF_YMIX);
  const float* dskip = p.in(IDSKIP) + l * 8;
  const float* ng = p.in(ISSDG) + (size_t)l * 512;
  const float* ka = p.in(IKA) + (size_t)l * 512; const float* rk = p.in(IRK) + (size_t)l * 512;
  const float* lg = p.in(ILNXG) + (size_t)l * 512; const float* lb = p.in(ILNXB) + (size_t)l * 512;
  const int c0 = lane * 8;
  float ngv[8], kav[8], rkv[8], lgv[8], lbv[8];
#pragma unroll
  for (int e = 0; e < 8; ++e) { ngv[e] = ng[c0 + e]; kav[e] = ka[c0 + e]; rkv[e] = rk[c0 + e]; lgv[e] = lg[c0 + e]; lbv[e] = lb[c0 + e]; }
  const float ds = dskip[lane >> 3];
#define POST_LOAD(D, tok_) do { const size_t o_ = (size_t)(tok_) * 512 + c0; \
    D[0] = ldnt16(ys + o_); D[1] = ldnt16(ys + (size_t)MTOK * 512 + o_); \
    D[2] = ldnt16(xs + o_); D[3] = ldnt16(sz + o_); \
    D[4] = ldnt16(yr + o_); D[5] = ldnt16(yr + (size_t)MTOK * 512 + o_); \
    D[6] = ldnt16(rr + o_); D[7] = ldnt16(kk_ + o_); D[8] = ldnt16(vv + o_); D[9] = ldnt16(gg + o_); \
    D[10] = ldnt16(aa + o_); D[11] = ldnt16(aa + (size_t)MTOK * 512 + o_); } while (0)
  int tok = c.bid * 8 + wave;
  uint4 L[12], N[12];
  if (tok < MTOK) POST_LOAD(L, tok);
  for (; tok < MTOK; tok += c.nb * 8) {
    const int ntok = tok + c.nb * 8;
    if (ntok < MTOK) POST_LOAD(N, ntok);
    {
      float f[8], bk[8], x[8], z[8];
      unpack8(L[0], f); unpack8(L[1], bk); unpack8(L[2], x); unpack8(L[3], z);
      float y[8]; float ss = 0.f;
#pragma unroll
      for (int e = 0; e < 8; ++e) { y[e] = (f[e] + bk[e] + ds * x[e]) * z[e]; ss += y[e] * y[e]; }
#pragma unroll
      for (int off = 16; off >= 1; off >>= 1) ss += __shfl_xor(ss, off);
      const float rs = rsqrtf(ss * (1.f / 256.f) + RMS_EPS);
      float ov[8];
#pragma unroll
      for (int e = 0; e < 8; ++e) ov[e] = y[e] * rs * ngv[e];
      *(uint4*)(ymix + (size_t)tok * 1024 + c0) = pack8(ov);
    }
    {
      float yf[8], yb[8], r[8], k[8], vf[8], gf[8], af[8], ab[8];
      unpack8(L[4], yf); unpack8(L[5], yb); unpack8(L[6], r); unpack8(L[7], k); unpack8(L[8], vf); unpack8(L[9], gf);
      unpack8(L[10], af); unpack8(L[11], ab);
      float y[8]; float sum = 0.f, bon = 0.f;
#pragma unroll
      for (int e = 0; e < 8; ++e) {
        y[e] = yf[e] + yb[e]; sum += y[e];
        bon += r[e] * k[e] * rkv[e] * (2.f + (af[e] + ab[e] - 2.f) * kav[e]);
      }
#pragma unroll
      for (int off = 4; off >= 1; off >>= 1) { sum += __shfl_xor(sum, off); bon += __shfl_xor(bon, off); }
      const float mean = sum * (1.f / 64.f);
      float sq = 0.f;
#pragma unroll
      for (int e = 0; e < 8; ++e) { float dlt = y[e] - mean; sq += dlt * dlt; }
#pragma unroll
      for (int off = 4; off >= 1; off >>= 1) sq += __shfl_xor(sq, off);
      const float rstd = rsqrtf(sq * (1.f / 64.f) + GN_EPS);
      float ov[8];
#pragma unroll
      for (int e = 0; e < 8; ++e) ov[e] = ((y[e] - mean) * rstd * lgv[e] + lbv[e] + bon * vf[e]) * gf[e];
      *(uint4*)(ymix + (size_t)tok * 1024 + 512 + c0) = pack8(ov);
    }
#pragma unroll
    for (int i = 0; i < 12; ++i) L[i] = N[i];
  }
#undef POST_LOAD
}

#define XB_TMO      128
#define XB_XCNT(j)  (256  + 64 * (j))
#define XB_XSUB(j)  (1280 + 64 * (j))
#define XB_XGEN(j)  (2304 + 64 * (j))
#define XB_TOP      3328
#define XB_TOPGEN   3392
#define XCD_BAR_WORDS 3456
#define XB_SPIN_CAP (1u << 18)
#define LAS __attribute__((address_space(3)))

__device__ __forceinline__ unsigned xb_ld(unsigned* p)              { return __hip_atomic_load(p, __ATOMIC_RELAXED, __HIP_MEMORY_SCOPE_AGENT); }
__device__ __forceinline__ unsigned xb_add(unsigned* p, unsigned v) { return __hip_atomic_fetch_add(p, v, __ATOMIC_RELAXED, __HIP_MEMORY_SCOPE_AGENT); }
__device__ __forceinline__ unsigned xb_xcc_id() { return (unsigned)__builtin_amdgcn_s_getreg((3 << 11) | 20) & 0xFu; }
#define XB_SPIN(cond, bar) do { unsigned _sp = 0; while (cond) { __builtin_amdgcn_s_sleep(1); \
    if ((++_sp & 255u) == 0u) { if (xb_ld(&(bar)[XB_TMO])) break; if (_sp > XB_SPIN_CAP) { atomicAdd(&(bar)[XB_TMO], 1u); break; } } } } while (0)

struct XcdBarrier {
    unsigned* bar; unsigned x; unsigned wv;
    volatile LAS unsigned* st;
};

__device__ __forceinline__ XcdBarrier xcd_barrier_post(unsigned* bar, volatile LAS unsigned* st) {
    XcdBarrier b; b.bar = bar; b.x = xb_xcc_id(); b.st = st; b.wv = (unsigned)__builtin_amdgcn_readfirstlane((int)(threadIdx.x >> 6));
    if (threadIdx.x == 0) (void)xb_add(&bar[XB_XCNT(b.x)], 1u);
    return b;
}
__device__ __forceinline__ void xcd_barrier_complete(unsigned* bar, unsigned x, unsigned& nloc, unsigned& nx) {
    const unsigned G = gridDim.x * gridDim.y * gridDim.z;
    unsigned sum, cnt, mine, sp = 0u;
    for (;;) {
        sum = 0u; cnt = 0u; mine = 0u;
#pragma unroll
        for (unsigned j = 0; j < 16; ++j) { const unsigned c = xb_ld(&bar[XB_XCNT(j)]); sum += c; cnt += (c > 0u) ? 1u : 0u; mine = (j == x) ? c : mine; }
        if (sum == G) break;
        __builtin_amdgcn_s_sleep(1);
        if ((++sp & 255u) == 0u) { if (xb_ld(&bar[XB_TMO])) break; if (sp > XB_SPIN_CAP) { atomicAdd(&bar[XB_TMO], 1u); break; } }
    }
    nloc = mine > 0u ? mine : 1u; nx = cnt > 0u ? cnt : 1u;
}

__device__ __forceinline__ void xcd_barrier(const XcdBarrier& b) {
    asm volatile("s_waitcnt vmcnt(0)" ::: "memory");
    __syncthreads();
    if (b.wv == 0u && lane_id_() == 0) {
        unsigned* bar = b.bar;
        __builtin_amdgcn_s_waitcnt(0);
        unsigned nloc = b.st[0], nx = b.st[1];
        if (nloc == 0u) { xcd_barrier_complete(bar, b.x, nloc, nx); b.st[0] = nloc; b.st[1] = nx; }
        const unsigned old = xb_add(&bar[XB_XSUB(b.x)], 1u);
        const unsigned gen = old / nloc;
        if (old + 1u == (gen + 1u) * nloc) {
            __builtin_amdgcn_fence(__ATOMIC_RELEASE, "agent");
            asm volatile("s_waitcnt vmcnt(0)" ::: "memory");
            const unsigned og = xb_add(&bar[XB_TOP], 1u);
            const unsigned tg = og / nx;
            if (og + 1u == (tg + 1u) * nx) xb_add(&bar[XB_TOPGEN], 1u);
            else XB_SPIN(xb_ld(&bar[XB_TOPGEN]) == tg, bar);
            __builtin_amdgcn_fence(__ATOMIC_ACQUIRE, "agent");
            xb_add(&bar[XB_XGEN(b.x)], 1u);
            asm volatile("s_waitcnt vmcnt(0)" ::: "memory");
        } else {
            XB_SPIN(xb_ld(&bar[XB_XGEN(b.x)]) == gen, bar);
            __builtin_amdgcn_fence(__ATOMIC_ACQUIRE, "agent");
            asm volatile("s_waitcnt vmcnt(0)" ::: "memory");
        }
    }
    __syncthreads();
}


constexpr int NPHASE = 21;

__device__ __forceinline__ void run_phase(const Ctx c, const PV& p, int ph, char* shm) {
  const int l = (ph == 0) ? 0 : (ph - 1) / 10, s = (ph == 0) ? -1 : (ph - 1) % 10;
  if (s == 0 || s == 2 || s == 5 || s == 7 || s == 8) {
    GemmDesc gd{};
    gd.eproj = EpiProj{(u16*)(p.ws() + OFF_P), (float*)(p.ws() + OFF_DTRAW)};
    gd.elora = EpiLora{(u16*)(p.ws() + OFF_E), (u16*)(p.ws() + OFF_A), (u16*)(p.ws() + OFF_G), p.in(IW0) + (size_t)l * 1024, p.in(IA0) + (size_t)l * 1024};
    gd.eresh = EpiResidB{(u16*)(p.ws() + OFF_PRE), (const u16*)p.out()};
    gd.eresb = EpiResidB{(u16*)(p.ws() + OFF_PRE), (const u16*)(p.ws() + OFF_H)};
    gd.erelu = EpiRelu2{(u16*)(p.ws() + OFF_ACT)};
    if (s == 0)      { gd.A = (const u16*)(p.ws() + OFF_H);    gd.Bt = (const u16*)(p.ws() + OFF_WIN);   gd.N = NPROJ; gd.K = DM;  gd.kind = 0; }
    else if (s == 2) { gd.A = (const u16*)(p.ws() + OFF_S);    gd.Bt = (const u16*)(p.ws() + OFF_WLORA); gd.N = 2560;  gd.K = 256; gd.kind = 1; }
    else if (s == 5) { gd.A = (const u16*)(p.ws() + OFF_YMIX); gd.Bt = (const u16*)(p.ws() + OFF_WOUT);  gd.N = DM;    gd.K = DM;  gd.kind = 2; }
    else if (s == 7) { gd.A = (const u16*)(p.ws() + OFF_H);    gd.Bt = (const u16*)(p.ws() + OFF_WFC);   gd.N = DFF;   gd.K = DM;  gd.kind = 3; }
    else             { gd.A = (const u16*)(p.ws() + OFF_ACT);  gd.Bt = (const u16*)(p.ws() + OFF_WPROJ); gd.N = DM;    gd.K = DFF; gd.kind = 4; }
    gemm_phase(c, gd, shm);
    return;
  }
  switch (s) {
    case -1:
#if PROBE_CLK
      if (c.tid < 256) {
        float a = (float)c.tid, b = 1.0000001f, cc = 1e-9f;
        for (int it = 0; it < 32768; ++it) { a = rowsum4(a) * b + cc; }
        if (a == 12345.678f) p.out()[0] = a;
      }
#endif
      ln_phase(c, p.in(IX), p.in(ILN0G), p.in(ILN0B), p.out(), (u16*)(p.ws() + OFF_H));
      convert_weights(c, p, 0, shm);
      break;
    case 1: prep_phase(c, p, l); break;
    case 3: mixer_phase(c, p, l, shm); break;
    case 4: post_phase(c, p, l); break;
    case 6: ln_phase_b(c, (const u16*)(p.ws() + OFF_PRE), p.in(ILN1G) + (size_t)l * DM, p.in(ILN1B) + (size_t)l * DM, p.out(), (u16*)(p.ws() + OFF_H), false, true, false); break;
    case 9:
      ln_phase_b(c, (const u16*)(p.ws() + OFF_PRE), p.in(ILN2G) + (size_t)l * DM, p.in(ILN2B) + (size_t)l * DM, p.out(), (u16*)(p.ws() + OFF_H), l != 0, l == 0, l == 0);
      if (l == 0) convert_weights(c, p, 1, shm);
      break;
    default: break;
  }
}

__global__ void __launch_bounds__(512) mega(Params p, int lo, int hi) {
  extern __shared__ __attribute__((aligned(16))) char shm[];
  volatile LAS unsigned* xst = (volatile LAS unsigned*)(shm + XB_LDS_OFF);
  if (threadIdx.x == 0) { xst[0] = 0u; xst[1] = 0u; xst[2] = 0u; xst[3] = 0u; }
  __syncthreads();
  XcdBarrier xb = xcd_barrier_post((unsigned*)(p.ws + OFF_BAR), xst);
  if (hi > 1000) cg::this_grid().sync();
#if PROBE_SYNC
  if (hi - lo > 1) { for (int i = 0; i < 20; ++i) xcd_barrier(xb); }
#endif
  for (int ph = lo; ph < hi; ++ph) {
    int reps = 1;
#if PROBE_REP
    if (ph > 0 && ((PROBE_REP >> ((ph - 1) % 10)) & 1)) reps = 2;
#endif
    for (int rep = 0; rep < reps; ++rep) {
      long z; int zi;
      asm volatile("s_mov_b64 %0, 0\n\ts_mov_b32 %1, 0" : "=s"(z), "=s"(zi));
      const PV q{p, z};
      int tidv = (int)xb.wv * 64 + lane_id_(); asm volatile("" : "+v"(tidv));
      Ctx c{tidv, (int)blockIdx.x + zi, (int)gridDim.x + zi};
      run_phase(c, q, ph, shm);
      if (rep + 1 < reps || ph + 1 < hi) { xcd_barrier(xb); }
    }
  }
}

extern "C" void kernel_launch(void* const* d_in, const int* in_sizes, int n_in, void* d_out, int out_size,
                              void* d_ws, size_t ws_size, hipStream_t stream) {
  if (ws_size < WS_NEED) { fprintf(stderr, "workspace too small: %zu < %zu\n", ws_size, WS_NEED); return; }
  Params p{};
  for (int i = 0; i < NIN; ++i) p.in[i] = (const float*)d_in[i];
  p.out = (float*)d_out;
  p.ws = (char*)d_ws;
  hipFuncSetAttribute((const void*)mega, hipFuncAttributeMaxDynamicSharedMemorySize, SHM_BYTES);
#if COOP
  hipMemsetAsync((char*)d_ws + OFF_BAR, 0, XCD_BAR_WORDS * sizeof(unsigned), stream);
  int lo = 0, hi = NPHASE;
  void* args[] = {&p, &lo, &hi};
  hipError_t e = hipLaunchCooperativeKernel((const void*)mega, dim3(256), dim3(512), args, SHM_BYTES, stream);
  if (e != hipSuccess) fprintf(stderr, "cooperative launch failed: %s\n", hipGetErrorString(e));
#else
  for (int ph = 0; ph < NPHASE; ++ph) mega<<<dim3(256), dim3(512), SHM_BYTES, stream>>>(p, ph, ph + 1);
#endif
}
```
